# Optimizing an MI355X kernel written in HIP

```python
import math
import jax
import jax.numpy as jnp
from jax import lax
import numpy as np

D_MODEL = 1024
BATCH = 16
SEQ = 4096
DEPTH = 1

CHUNK = 64
Q_BLOCK = 128
ATT_HEADS = 8
HEAD_DIM = 64
ATT_WIDTH = ATT_HEADS * HEAD_DIM
LRU_WIDTH = D_MODEL - ATT_WIDTH
LRU_BLOCKS = 8
LRU_BLOCK_DIM = LRU_WIDTH // LRU_BLOCKS
CONV_WIDTH = 4
LRU_C = 8.0
D_FF = -(-8 * D_MODEL // (3 * 256)) * 256
IN_WIDTH = 3 * ATT_WIDTH + ATT_HEADS + 2 * LRU_WIDTH
NORM_EPS = 1e-6

kernel_name = "hymba_fox_rglru_swiglu_layer"


def rmsnorm(x, g):
    xf = x.astype(jnp.float32)
    y = xf * lax.rsqrt(jnp.mean(xf * xf, axis=-1, keepdims=True) + NORM_EPS)
    return (y * g.astype(jnp.float32)).astype(x.dtype)


def forgetting_attention(q, k, v, cum_logf):
    seq = q.shape[2]
    scale = 1.0 / math.sqrt(HEAD_DIM)
    outs = []
    for start in range(0, seq, Q_BLOCK):
        end = start + Q_BLOCK
        qb = q[:, :, start:end]
        kb = k[:, :, :end]
        vb = v[:, :, :end]
        s = jnp.einsum('bhqd,bhkd->bhqk', qb, kb).astype(jnp.float32) * scale
        s = s + (cum_logf[:, :, start:end, None] - cum_logf[:, :, None, :end])
        mask = jnp.arange(start, end)[:, None] >= jnp.arange(end)[None, :]
        s = jnp.where(mask[None, None], s, -jnp.inf)
        p = jax.nn.softmax(s, axis=-1).astype(vb.dtype)
        outs.append(jnp.einsum('bhqk,bhkd->bhqd', p, vb))
    return jnp.concatenate(outs, axis=2)


def causal_depthwise_conv(x, w, b):
    seq = x.shape[1]
    xp = jnp.pad(x, ((0, 0), (CONV_WIDTH - 1, 0), (0, 0)))
    y = b
    for j in range(CONV_WIDTH):
        y = y + xp[:, j:j + seq] * w[j]
    return y


def _lin_combine(c1, c2):
    a1, b1 = c1
    a2, b2 = c2
    return a1 * a2, a2 * b1 + b2


def rg_lru(x, w_a, b_a, w_x, b_x, lam):
    bsz, seq, ch = x.shape
    xb = x.reshape(bsz, seq, LRU_BLOCKS, LRU_BLOCK_DIM)
    gate_a = jnp.einsum('bsnd,nde->bsne', xb, w_a).reshape(bsz, seq, ch) + b_a
    gate_x = jnp.einsum('bsnd,nde->bsne', xb, w_x).reshape(bsz, seq, ch) + b_x
    r = jax.nn.sigmoid(gate_a.astype(jnp.float32))
    i = jax.nn.sigmoid(gate_x.astype(jnp.float32))
    log_a = -LRU_C * r * jax.nn.softplus(-lam.astype(jnp.float32))
    a = jnp.exp(log_a)
    u = jnp.sqrt(-jnp.expm1(2.0 * log_a)) * (i * x.astype(jnp.float32))
    _, h = lax.associative_scan(_lin_combine, (a, u), axis=1)
    return h.astype(x.dtype)


def setup_inputs(seed: int = 0) -> dict:
    key = jax.random.key(seed)
    ks = jax.random.split(key, 20)
    f32 = jnp.float32
    nrm = lambda k, shape, s: jax.random.normal(k, shape, f32) * s
    x = jax.random.normal(ks[0], (BATCH, SEQ, D_MODEL), f32)
    norm1_g = 1.0 + nrm(ks[1], (DEPTH, D_MODEL), 0.02)
    w_in = nrm(ks[2], (DEPTH, D_MODEL, IN_WIDTH), D_MODEL ** -0.5)
    q_norm_g = 1.0 + nrm(ks[3], (DEPTH, HEAD_DIM), 0.02)
    k_norm_g = 1.0 + nrm(ks[4], (DEPTH, HEAD_DIM), 0.02)
    b_f = 2.0 + nrm(ks[5], (DEPTH, ATT_HEADS), 0.5)
    conv_w = nrm(ks[6], (DEPTH, CONV_WIDTH, LRU_WIDTH), CONV_WIDTH ** -0.5)
    conv_b = nrm(ks[7], (DEPTH, LRU_WIDTH), 0.01)
    w_a = nrm(ks[8], (DEPTH, LRU_BLOCKS, LRU_BLOCK_DIM, LRU_BLOCK_DIM), LRU_BLOCK_DIM ** -0.5)
    b_a = nrm(ks[9], (DEPTH, LRU_WIDTH), 0.01)
    w_x = nrm(ks[10], (DEPTH, LRU_BLOCKS, LRU_BLOCK_DIM, LRU_BLOCK_DIM), LRU_BLOCK_DIM ** -0.5)
    b_x = nrm(ks[11], (DEPTH, LRU_WIDTH), 0.01)
    ac = jax.random.uniform(ks[12], (DEPTH, LRU_WIDTH), f32, 0.9, 0.999)
    a0 = ac ** (1.0 / LRU_C)
    lam = jnp.log(a0) - jnp.log1p(-a0)
    attn_out_g = 1.0 + nrm(ks[13], (DEPTH, ATT_WIDTH), 0.02)
    lru_out_g = 1.0 + nrm(ks[14], (DEPTH, LRU_WIDTH), 0.02)
    w_out = nrm(ks[15], (DEPTH, D_MODEL, D_MODEL), D_MODEL ** -0.5)
    norm2_g = 1.0 + nrm(ks[16], (DEPTH, D_MODEL), 0.02)
    w_gate = nrm(ks[17], (DEPTH, D_MODEL, D_FF), D_MODEL ** -0.5)
    w_up = nrm(ks[18], (DEPTH, D_MODEL, D_FF), D_MODEL ** -0.5)
    w_down = nrm(ks[19], (DEPTH, D_FF, D_MODEL), D_FF ** -0.5)
    return {"x": x, "norm1_g": norm1_g, "w_in": w_in, "q_norm_g": q_norm_g,
            "k_norm_g": k_norm_g, "b_f": b_f, "conv_w": conv_w, "conv_b": conv_b,
            "w_a": w_a, "b_a": b_a, "w_x": w_x, "b_x": b_x, "lam": lam,
            "attn_out_g": attn_out_g, "lru_out_g": lru_out_g, "w_out": w_out,
            "norm2_g": norm2_g, "w_gate": w_gate, "w_up": w_up, "w_down": w_down}


def reference(x, norm1_g, w_in, q_norm_g, k_norm_g, b_f, conv_w, conv_b, w_a, b_a,
              w_x, b_x, lam, attn_out_g, lru_out_g, w_out, norm2_g, w_gate, w_up,
              w_down):
    bsz, seq, _ = x.shape
    split_at = [ATT_WIDTH, 2 * ATT_WIDTH, 3 * ATT_WIDTH, 3 * ATT_WIDTH + ATT_HEADS,
                3 * ATT_WIDTH + ATT_HEADS + LRU_WIDTH]
    for l in range(DEPTH):
        h = rmsnorm(x, norm1_g[l])
        proj = h @ w_in[l]
        q, k, v, f_logit, lru_x, lru_gate = jnp.split(proj, split_at, axis=-1)

        q = rmsnorm(q.reshape(bsz, seq, ATT_HEADS, HEAD_DIM), q_norm_g[l])
        k = rmsnorm(k.reshape(bsz, seq, ATT_HEADS, HEAD_DIM), k_norm_g[l])
        v = v.reshape(bsz, seq, ATT_HEADS, HEAD_DIM)
        q, k, v = (t.transpose(0, 2, 1, 3) for t in (q, k, v))
        log_f = jax.nn.log_sigmoid(f_logit.astype(jnp.float32) + b_f[l].astype(jnp.float32))
        cum_logf = jnp.cumsum(log_f, axis=1).transpose(0, 2, 1)
        att = forgetting_attention(q, k, v, cum_logf)
        att = att.transpose(0, 2, 1, 3).reshape(bsz, seq, ATT_WIDTH)

        xc = causal_depthwise_conv(lru_x, conv_w[l], conv_b[l])
        hr = rg_lru(xc, w_a[l], b_a[l], w_x[l], b_x[l], lam[l])
        rec = hr * jax.nn.gelu(lru_gate)

        mixed = jnp.concatenate([rmsnorm(att, attn_out_g[l]), rmsnorm(rec, lru_out_g[l])], axis=-1)
        x = x + mixed @ w_out[l]

        h2 = rmsnorm(x, norm2_g[l])
        x = x + (jax.nn.silu(h2 @ w_gate[l]) * (h2 @ w_up[l])) @ w_down[l]
    return x
```

```cpp
#include <hip/hip_runtime.h>
#include <hip/hip_cooperative_groups.h>
#include <cstdio>
#include <cstdint>
namespace cg = cooperative_groups;
namespace pg8 {
#define PG8_LAS __attribute__((address_space(3)))
typedef unsigned short bf16_t;
typedef short bf16x8 __attribute__((ext_vector_type(8)));
typedef float f32x4 __attribute__((ext_vector_type(4)));
typedef unsigned u32x4 __attribute__((ext_vector_type(4)));
constexpr int BM = 256, BK = 64, HALF = 128, HTB = HALF * BK * 2  , STAGE_BYTES = 8 * HTB, NXCD = 8, WGM = 8;

__host__ __device__ __forceinline__ int lds_byte(int r, int c) { const int st = (r >> 4) * 2 + (c >> 5), rr = r & 15, cc = c & 31, ob = rr * 64 + cc * 2; return st * 1024 + (ob ^ (((ob >> 9) & 1) << 5)); }
__host__ __device__ __forceinline__ void stage_rc(int b, int& R, int& C) { const int st = b / 1024, sb = b % 1024, swz = sb ^ (((sb >> 9) & 1) << 5); R = (st >> 1) * 16 + swz / 64; C = (st & 1) * 32 + (swz % 64) / 2; }
__host__ __device__ __forceinline__ int perm32(int rho) { const int n = rho >> 4, i = rho & 15; return 8 * (i >> 2) + 4 * n + (i & 3); }

struct Unit { int pm, pn; };
struct Gemm { const bf16_t* A; const bf16_t* Bt; int M, N, K; };

struct StaticOrder {
    int nM, nN, nwg, G, c;
    __host__ __device__ void init(int M, int N, int G_, int c_) { nM = M / BM; nN = N / BM; nwg = nM * nN; G = G_; c = c_; }
    __host__ __device__ bool next(int i, Unit& u) const {
        const long L = (long)i * G + c; if (L >= nwg) return false;
        int wgid = (int)L; { const int q = nwg / NXCD, r = nwg % NXCD, xcd = wgid % NXCD, off = wgid / NXCD; wgid = (xcd < r ? xcd * (q + 1) : r * (q + 1) + (xcd - r) * q) + off; }
        const int nig = WGM * nN, gid = wgid / nig, fm = gid * WGM, gsz = (nM - fm) < WGM ? (nM - fm) : WGM;
        u.pm = fm + ((wgid % nig) % gsz); u.pn = (wgid % nig) / gsz; return true;
    }
    __device__ __forceinline__ void a_ready(const Unit&) const {}
    __device__ __forceinline__ void done(const Unit&) const {}
};

__device__ __forceinline__ unsigned cvt_pk_bf16(float lo, float hi) { unsigned r; asm volatile("v_cvt_pk_bf16_f32 %0, %1, %2" : "=v"(r) : "v"(lo), "v"(hi)); return r; }
typedef float f32x2 __attribute__((ext_vector_type(2)));
__device__ __forceinline__ float fast_rcp(float x) { return __builtin_amdgcn_rcpf(x); }
__device__ __forceinline__ float fast_exp(float x) { return __builtin_amdgcn_exp2f(x * 1.4426950408889634f); }
template <bool NT = false> __device__ __forceinline__ void stage_rows128(PG8_LAS unsigned char* stg, int fr, int lane, int cA, u32x4 dA, int cB, u32x4 dB, char* g0, size_t pitch) {
    *(PG8_LAS u32x4*)(stg + fr * 128 + ((cA ^ (fr & 7)) << 4)) = dA;
    *(PG8_LAS u32x4*)(stg + fr * 128 + ((cB ^ (fr & 7)) << 4)) = dB;
    const int r = lane >> 3, c = lane & 7;
    const u32x4 v0 = *(const PG8_LAS u32x4*)(stg + r * 128 + ((c ^ r) << 4));
    const u32x4 v1 = *(const PG8_LAS u32x4*)(stg + (r + 8) * 128 + ((c ^ r) << 4));
    if (NT) { __builtin_nontemporal_store(v0, (u32x4*)(g0 + (size_t)r * pitch + c * 16)); __builtin_nontemporal_store(v1, (u32x4*)(g0 + (size_t)(r + 8) * pitch + c * 16)); }
    else { *(u32x4*)(g0 + (size_t)r * pitch + c * 16) = v0; *(u32x4*)(g0 + (size_t)(r + 8) * pitch + c * 16) = v1; }
}
__device__ __forceinline__ void unstage_issue(const char* g0, size_t pitch, int lane, u32x4& v0, u32x4& v1) {
    const int r = lane >> 3, c = lane & 7;
    v0 = __builtin_nontemporal_load((const u32x4*)(g0 + (size_t)r * pitch + c * 16)); v1 = __builtin_nontemporal_load((const u32x4*)(g0 + (size_t)(r + 8) * pitch + c * 16));
}
__device__ __forceinline__ void unstage_take(PG8_LAS unsigned char* stg, int fr, int lane, const u32x4& v0, const u32x4& v1, int cA, u32x4& dA, int cB, u32x4& dB) {
    const int r = lane >> 3, c = lane & 7;
    *(PG8_LAS u32x4*)(stg + r * 128 + ((c ^ r) << 4)) = v0;
    *(PG8_LAS u32x4*)(stg + (r + 8) * 128 + ((c ^ r) << 4)) = v1;
    dA = *(const PG8_LAS u32x4*)(stg + fr * 128 + ((cA ^ (fr & 7)) << 4));
    dB = *(const PG8_LAS u32x4*)(stg + fr * 128 + ((cB ^ (fr & 7)) << 4));
}
__device__ __forceinline__ void stage_rows64(PG8_LAS unsigned char* stg, int fr, int fq, int lane, u32x4 dA, u32x4 dB, char* g0, char* g1, size_t pitch) {
    *(PG8_LAS u32x4*)(stg + fr * 64 + ((fq ^ ((fr >> 1) & 3)) << 4)) = dA;
    *(PG8_LAS u32x4*)(stg + (16 + fr) * 64 + ((fq ^ ((fr >> 1) & 3)) << 4)) = dB;
    const int r = lane >> 2, c = lane & 3;
    const u32x4 v0 = *(const PG8_LAS u32x4*)(stg + r * 64 + ((c ^ ((r >> 1) & 3)) << 4));
    const u32x4 v1 = *(const PG8_LAS u32x4*)(stg + (16 + r) * 64 + ((c ^ ((r >> 1) & 3)) << 4));
    __builtin_nontemporal_store(v0, (u32x4*)(g0 + (size_t)r * pitch + c * 16));
    __builtin_nontemporal_store(v1, (u32x4*)(g1 + (size_t)r * pitch + c * 16));
}
struct EpiProj {
    static constexpr bool PERM = true, AFTER_DRAIN = false;
    bf16_t* base; size_t stride; const float* gq; const float* gk; float qscale; const float* rs1;
    __device__ __forceinline__ void operator()(const f32x4 (&acc)[2][2][4][2], const Unit& u, int wr, int wc, int fr, int fq, PG8_LAS unsigned char* stg, int lane) const {
        const int kind = u.pn >> 1;
        bf16_t* dst = base + (size_t)kind * stride;
        const int rowg = u.pm * BM + wr * 64;
        const int colw = (u.pn & 1) * 256 + 64 * wc;
        float rsv[2][4];
#pragma unroll
        for (int ai = 0; ai < 2; ++ai)
#pragma unroll
            for (int m = 0; m < 4; ++m) rsv[ai][m] = rs1[rowg + ai * HALF + m * 16 + fr];
        if (kind < 2) {
            const float* g = (kind == 0) ? gq : gk; const float sc = (kind == 0) ? qscale : 1.f;
            f32x4 gv[2][2];
#pragma unroll
            for (int bj = 0; bj < 2; ++bj)
#pragma unroll
                for (int n = 0; n < 2; ++n) gv[bj][n] = *(const f32x4*)(g + 32 * bj + 8 * fq + 4 * n) * sc;
#pragma unroll
            for (int ai = 0; ai < 2; ++ai)
#pragma unroll
                for (int m = 0; m < 4; ++m) {
                    float ss = 0.f;
#pragma unroll
                    for (int bj = 0; bj < 2; ++bj)
#pragma unroll
                        for (int n = 0; n < 2; ++n) { const f32x4 x = acc[ai][bj][m][n]; ss += (x[0] * x[0] + x[1] * x[1]) + (x[2] * x[2] + x[3] * x[3]); }
                    ss += __shfl_xor(ss, 16); ss += __shfl_xor(ss, 32);
                    const float r1 = rsv[ai][m], rs = r1 * rsqrtf(r1 * r1 * ss * (1.0f / 64.0f) + 1e-6f);
                    u32x4 w[2];
#pragma unroll
                    for (int bj = 0; bj < 2; ++bj) { const f32x4 v0 = acc[ai][bj][m][0] * rs * gv[bj][0], v1 = acc[ai][bj][m][1] * rs * gv[bj][1];
                        w[bj].x = cvt_pk_bf16(v0[0], v0[1]); w[bj].y = cvt_pk_bf16(v0[2], v0[3]); w[bj].z = cvt_pk_bf16(v1[0], v1[1]); w[bj].w = cvt_pk_bf16(v1[2], v1[3]); }
                    stage_rows128<true>(stg, fr, lane, fq, w[0], 4 + fq, w[1], (char*)(dst + (size_t)(rowg + ai * HALF + m * 16) * 512 + colw), 1024);
                }
        } else {
#pragma unroll
            for (int ai = 0; ai < 2; ++ai)
#pragma unroll
                for (int m = 0; m < 4; ++m) { u32x4 w[2];
#pragma unroll
                    for (int bj = 0; bj < 2; ++bj) { const f32x4 v0 = acc[ai][bj][m][0] * rsv[ai][m], v1 = acc[ai][bj][m][1] * rsv[ai][m];
                        w[bj].x = cvt_pk_bf16(v0[0], v0[1]); w[bj].y = cvt_pk_bf16(v0[2], v0[3]); w[bj].z = cvt_pk_bf16(v1[0], v1[1]); w[bj].w = cvt_pk_bf16(v1[2], v1[3]); }
                    stage_rows128<true>(stg, fr, lane, fq, w[0], 4 + fq, w[1], (char*)(dst + (size_t)(rowg + ai * HALF + m * 16) * 512 + colw), 1024); }
        }
    }
};
struct EpiSwiGLU {
    static constexpr bool PERM = true, AFTER_DRAIN = false;
    bf16_t* O; int ldc; const float* rss;
    __device__ __forceinline__ void operator()(const f32x4 (&acc)[2][2][4][2], const Unit& u, int wr, int wc, int fr, int fq, PG8_LAS unsigned char* stg, int lane) const {
        const int row0 = u.pm * BM + wr * 64 + fr, col0 = u.pn * 128 + wc * 32 + 8 * fq;
        float rsv[2][4];
#pragma unroll
        for (int ai = 0; ai < 2; ++ai)
#pragma unroll
            for (int m = 0; m < 4; ++m) rsv[ai][m] = rsqrtf(rss[row0 + ai * HALF + m * 16] * (1.0f / 1024.0f) + 1e-6f);
#pragma unroll
        for (int ai = 0; ai < 2; ++ai)
#pragma unroll
            for (int mp = 0; mp < 2; ++mp) { u32x4 w[2];
#pragma unroll
                for (int mm = 0; mm < 2; ++mm) { const int m = 2 * mp + mm; f32x4 a[2];
                    const float rs = rsv[ai][m], ce = -1.4426950408889634f * rs, rs2 = rs * rs;
#pragma unroll
                    for (int n = 0; n < 2; ++n) { const f32x4 g = acc[ai][0][m][n], gu = g * acc[ai][1][m][n]; f32x4 e = g * ce;
#pragma unroll
                        for (int i = 0; i < 4; ++i) e[i] = __builtin_amdgcn_exp2f(e[i]);
                        e = e + 1.0f;
#pragma unroll
                        for (int i = 0; i < 4; ++i) e[i] = __builtin_amdgcn_rcpf(e[i]);
                        a[n] = gu * (e * rs2); }
                    w[mm].x = cvt_pk_bf16(a[0][0], a[0][1]); w[mm].y = cvt_pk_bf16(a[0][2], a[0][3]); w[mm].z = cvt_pk_bf16(a[1][0], a[1][1]); w[mm].w = cvt_pk_bf16(a[1][2], a[1][3]); }
                char* g0 = (char*)(O + (size_t)(u.pm * BM + wr * 64 + ai * HALF + 32 * mp) * ldc + u.pn * 128 + wc * 32);
                stage_rows64(stg, fr, fq, lane, w[0], w[1], g0, g0 + (size_t)16 * ldc * 2, (size_t)ldc * 2); }
    }
};
struct EpiResNorm {
    static constexpr bool PERM = true, AFTER_DRAIN = false;
    const bf16_t* base; bf16_t* xb; float* rss; int ldc;
    __device__ __forceinline__ void operator()(const f32x4 (&acc)[2][2][4][2], const Unit& u, int wr, int wc, int fr, int fq, PG8_LAS unsigned char* stg, int lane) const {
        const int rowg = u.pm * BM + wr * 64, colw = u.pn * BM + 64 * wc;
        u32x4 l0[2][4], l1[2][4];
        { const int r = lane >> 3, c = lane & 7; const bf16_t* gp = base + (size_t)rowg * ldc + colw + c * 8;
#pragma unroll
          for (int ai = 0; ai < 2; ++ai)
#pragma unroll
              for (int m = 0; m < 4; ++m) { l0[ai][m] = __builtin_nontemporal_load((const u32x4*)(gp + (size_t)(ai * HALF + m * 16 + r) * ldc)); l1[ai][m] = __builtin_nontemporal_load((const u32x4*)(gp + (size_t)(ai * HALF + m * 16 + r + 8) * ldc)); } }
#pragma unroll
        for (int ai = 0; ai < 2; ++ai)
#pragma unroll
            for (int m = 0; m < 4; ++m) { const int row = rowg + ai * HALF + m * 16 + fr; float ss = 0.f; u32x4 w[2];
                u32x4 rb[2]; unstage_take(stg, fr, lane, l0[ai][m], l1[ai][m], fq, rb[0], 4 + fq, rb[1]);
#pragma unroll
                for (int bj = 0; bj < 2; ++bj) { const u32x4 b = rb[bj]; f32x4 v[2];
                    v[0] = (f32x4){__uint_as_float(b.x << 16), __uint_as_float(b.x & 0xffff0000u), __uint_as_float(b.y << 16), __uint_as_float(b.y & 0xffff0000u)} + acc[ai][bj][m][0];
                    v[1] = (f32x4){__uint_as_float(b.z << 16), __uint_as_float(b.z & 0xffff0000u), __uint_as_float(b.w << 16), __uint_as_float(b.w & 0xffff0000u)} + acc[ai][bj][m][1];
#pragma unroll
                    for (int n = 0; n < 2; ++n) ss += (v[n][0] * v[n][0] + v[n][1] * v[n][1]) + (v[n][2] * v[n][2] + v[n][3] * v[n][3]);
                    w[bj].x = cvt_pk_bf16(v[0][0], v[0][1]); w[bj].y = cvt_pk_bf16(v[0][2], v[0][3]); w[bj].z = cvt_pk_bf16(v[1][0], v[1][1]); w[bj].w = cvt_pk_bf16(v[1][2], v[1][3]); }
                stage_rows128(stg, fr, lane, fq, w[0], 4 + fq, w[1], (char*)(xb + (size_t)(rowg + ai * HALF + m * 16) * ldc + colw), (size_t)ldc * 2);
                ss += __shfl_xor(ss, 16); ss += __shfl_xor(ss, 32);
                if (fq == 0) atomicAdd(rss + row, ss); }
    }
};
struct EpiRes {
    static constexpr bool PERM = true, AFTER_DRAIN = false;
    const bf16_t* base; float* out; int ldc;
    __device__ __forceinline__ void operator()(const f32x4 (&acc)[2][2][4][2], const Unit& u, int wr, int wc, int fr, int fq, PG8_LAS unsigned char* stg, int lane) const {
        u32x4 l0[2][4], l1[2][4];
        { const int r = lane >> 3, c = lane & 7; const bf16_t* gp = base + (size_t)(u.pm * BM + wr * 64) * ldc + u.pn * BM + wc * 32 + (c >> 2) * HALF + (c & 3) * 8;
#pragma unroll
          for (int ai = 0; ai < 2; ++ai)
#pragma unroll
              for (int m = 0; m < 4; ++m) { l0[ai][m] = __builtin_nontemporal_load((const u32x4*)(gp + (size_t)(ai * HALF + m * 16 + r) * ldc)); l1[ai][m] = __builtin_nontemporal_load((const u32x4*)(gp + (size_t)(ai * HALF + m * 16 + r + 8) * ldc)); } }
#pragma unroll
        for (int ai = 0; ai < 2; ++ai)
#pragma unroll
            for (int m = 0; m < 4; ++m) {
                u32x4 rb[2]; unstage_take(stg, fr, lane, l0[ai][m], l1[ai][m], fq, rb[0], 4 + fq, rb[1]);
#pragma unroll
                for (int bj = 0; bj < 2; ++bj) { const u32x4 b = rb[bj];
                    const f32x4 b0 = {__uint_as_float(b.x << 16), __uint_as_float(b.x & 0xffff0000u), __uint_as_float(b.y << 16), __uint_as_float(b.y & 0xffff0000u)};
                    const f32x4 b1 = {__uint_as_float(b.z << 16), __uint_as_float(b.z & 0xffff0000u), __uint_as_float(b.w << 16), __uint_as_float(b.w & 0xffff0000u)};
                    const f32x4 o0 = b0 + acc[ai][bj][m][0], o1 = b1 + acc[ai][bj][m][1];
                    stage_rows128<true>(stg, fr, lane, 2 * fq, __builtin_bit_cast(u32x4, o0), 2 * fq + 1, __builtin_bit_cast(u32x4, o1),
                                  (char*)(out + (size_t)(u.pm * BM + wr * 64 + ai * HALF + m * 16) * ldc + u.pn * BM + bj * HALF + wc * 32), (size_t)ldc * 4); } }
    }
};
template <class Epi, class Sched, bool ALIGN_EPI = false, bool SP2 = false>
__device__ __forceinline__ void gemm_phase(PG8_LAS unsigned char* lds, const Gemm g, const Sched& S, const Epi& E) {
    int tid_ = threadIdx.x; asm volatile("" : "+v"(tid_));
    const int tid = tid_, wid = __builtin_amdgcn_readfirstlane(tid >> 6), lane = tid & 63, wr = wid >> 2, wc = wid & 3, fr = lane & 15, fq = lane >> 4;
    const int K = g.K, nt = K / BK;
    unsigned voffA[2], voffB[2];
#pragma unroll
    for (int i = 0; i < 2; ++i) { int R, C; stage_rc(tid * 16 + i * 8192, R, C); const int Rb = Epi::PERM ? ((R & ~31) + perm32(R & 31)) : R;
        voffA[i] = (unsigned)(R * K + C) * 2u; voffB[i] = (unsigned)(Rb * K + C) * 2u; }
    const size_t kstep = (size_t)(BK * 2);
    const size_t hstep = (size_t)HALF * K * 2;
    const size_t tstep = 2 * hstep;
    const unsigned ldsw = (unsigned)wid * 1024u;
    const int aoff = lds_byte(wr * 64 + fr, fq * 8), boff = lds_byte(wc * 32 + fr, fq * 8);
#define PG8_SA(b, h) (((b) * 2 + (h)) * HTB)
#define PG8_SB(b, h) ((4 + (b) * 2 + (h)) * HTB)
#define PG8_STAGE(bufoff, gbase, voff) do { _Pragma("unroll") for (int _i = 0; _i < 2; ++_i) \
        __builtin_amdgcn_global_load_lds((const unsigned*)((const char*)(gbase) + (voff)[_i]), (PG8_LAS unsigned*)(lds + (bufoff) + ldsw + _i * 8192), 16, 0, 0); } while (0)
#define PG8_LDA(dst, b, h) do { _Pragma("unroll") for (int m = 0; m < 4; ++m) _Pragma("unroll") for (int k = 0; k < 2; ++k) dst[m][k] = *(const PG8_LAS bf16x8*)(lds + PG8_SA(b, h) + aoff + m * 2048 + k * 1024); } while (0)
#define PG8_LDB(dst, b, h) do { _Pragma("unroll") for (int n = 0; n < 2; ++n) _Pragma("unroll") for (int k = 0; k < 2; ++k) dst[n][k] = *(const PG8_LAS bf16x8*)(lds + PG8_SB(b, h) + boff + n * 2048 + k * 1024); } while (0)
#define PG8_MMA(ai, bj, At, Bt) do { __builtin_amdgcn_s_setprio(1); _Pragma("unroll") for (int m = 0; m < 4; ++m) _Pragma("unroll") for (int n = 0; n < 2; ++n) _Pragma("unroll") for (int k = 0; k < 2; ++k) \
        acc[ai][bj][m][n] = __builtin_amdgcn_mfma_f32_16x16x32_bf16(Bt[n][k], At[m][k], acc[ai][bj][m][n], 0, 0, 0); __builtin_amdgcn_s_setprio(0); } while (0)
#define PG8_WAIT_V(n) asm volatile("s_waitcnt vmcnt(" #n ")" ::: "memory")
#define PG8_WAIT_L(n) asm volatile("s_waitcnt lgkmcnt(" #n ")" ::: "memory")
#define PG8_BAR __builtin_amdgcn_s_barrier()
#define PG8_SCHED __builtin_amdgcn_sched_barrier(0)
    Unit cur, nxt; int ui = 0;
    if (!S.next(0, cur)) return;
    f32x4 acc[2][2][4][2];
#pragma unroll
    for (int a = 0; a < 2; ++a)
#pragma unroll
        for (int b = 0; b < 2; ++b)
#pragma unroll
            for (int m = 0; m < 4; ++m)
#pragma unroll
                for (int n = 0; n < 2; ++n) acc[a][b][m][n] = (f32x4){0.f, 0.f, 0.f, 0.f};
    bf16x8 At[4][2], B0[2][2], B1[2][2];
    const char* cA = (const char*)g.A + (size_t)cur.pm * tstep; const char* cB = (const char*)g.Bt + (size_t)cur.pn * tstep;
    S.a_ready(cur);
    if constexpr (SP2) {
        PG8_STAGE(PG8_SB(0, 0), cB, voffB); PG8_STAGE(PG8_SB(0, 1), cB + hstep, voffB); PG8_STAGE(PG8_SA(0, 0), cA, voffA); PG8_STAGE(PG8_SA(0, 1), cA + hstep, voffA);
        if (wr == 1) PG8_BAR;
        PG8_WAIT_V(2); PG8_BAR;
        PG8_STAGE(PG8_SB(1, 0), cB + kstep, voffB); PG8_STAGE(PG8_SA(1, 0), cA + kstep, voffA); PG8_STAGE(PG8_SB(1, 1), cB + hstep + kstep, voffB);
        PG8_WAIT_V(6); PG8_BAR;
    } else {
        PG8_STAGE(PG8_SB(0, 0), cB, voffB); PG8_STAGE(PG8_SA(0, 0), cA, voffA); PG8_STAGE(PG8_SB(0, 1), cB + hstep, voffB); PG8_STAGE(PG8_SA(0, 1), cA + hstep, voffA);
        if (wr == 1) PG8_BAR;
        PG8_WAIT_V(4); PG8_BAR;
        PG8_STAGE(PG8_SB(1, 0), cB + kstep, voffB); PG8_STAGE(PG8_SA(1, 0), cA + kstep, voffA); PG8_STAGE(PG8_SB(1, 1), cB + hstep + kstep, voffB);
        PG8_WAIT_V(6); PG8_BAR;
    }
    for (;;) {
        const bool has_next = S.next(ui + 1, nxt);
        const char* nA = has_next ? (const char*)g.A + (size_t)nxt.pm * tstep : cA; const char* nB = has_next ? (const char*)g.Bt + (size_t)nxt.pn * tstep : cB;
        for (int t = 0; t < nt; t += 2) {
            const bool last = (t == nt - 2);
            const char* a1 = cA + (size_t)(t + 1) * kstep;
            const char* a2 = last ? nA : cA + (size_t)(t + 2) * kstep; const char* b2 = last ? nB : cB + (size_t)(t + 2) * kstep;
            const char* a3 = a2 + kstep; const char* b3 = b2 + kstep;
            if (last && has_next) S.a_ready(nxt);
            if constexpr (SP2) {
            PG8_LDB(B0, 0, 0); PG8_LDB(B1, 0, 1); PG8_SCHED; PG8_LDA(At, 0, 0); PG8_STAGE(PG8_SA(1, 1), a1 + hstep, voffA);
            PG8_WAIT_V(8); PG8_WAIT_L(0); PG8_BAR; PG8_MMA(0, 0, At, B0); PG8_MMA(0, 1, At, B1); PG8_BAR; PG8_SCHED;
            PG8_LDA(At, 0, 1); PG8_STAGE(PG8_SB(0, 0), b2, voffB); PG8_STAGE(PG8_SB(0, 1), b2 + hstep, voffB); PG8_STAGE(PG8_SA(0, 0), a2, voffA);
            PG8_WAIT_V(8); PG8_WAIT_L(0); PG8_BAR; PG8_MMA(1, 0, At, B0); PG8_MMA(1, 1, At, B1); PG8_BAR; PG8_SCHED;
            PG8_LDB(B0, 1, 0); PG8_LDB(B1, 1, 1); PG8_SCHED; PG8_LDA(At, 1, 0); PG8_STAGE(PG8_SA(0, 1), a2 + hstep, voffA);
            PG8_WAIT_V(8); PG8_WAIT_L(0); PG8_BAR; PG8_MMA(0, 0, At, B0); PG8_MMA(0, 1, At, B1); PG8_BAR; PG8_SCHED;
            PG8_LDA(At, 1, 1); PG8_STAGE(PG8_SB(1, 0), b3, voffB); PG8_STAGE(PG8_SB(1, 1), b3 + hstep, voffB); PG8_STAGE(PG8_SA(1, 0), a3, voffA);
            PG8_WAIT_V(8); PG8_WAIT_L(0); PG8_BAR; PG8_MMA(1, 0, At, B0); PG8_MMA(1, 1, At, B1); PG8_BAR; PG8_SCHED;
            } else {
            PG8_LDB(B0, 0, 0); PG8_SCHED; PG8_LDA(At, 0, 0); PG8_STAGE(PG8_SA(1, 1), a1 + hstep, voffA);
            PG8_WAIT_L(8); PG8_BAR; PG8_WAIT_L(0); PG8_MMA(0, 0, At, B0); PG8_BAR; PG8_SCHED;
            PG8_LDB(B1, 0, 1); PG8_STAGE(PG8_SB(0, 0), b2, voffB);
            PG8_BAR; PG8_WAIT_L(0); PG8_MMA(0, 1, At, B1); PG8_BAR;
            PG8_LDA(At, 0, 1); PG8_STAGE(PG8_SA(0, 0), a2, voffA);
            PG8_BAR; PG8_WAIT_L(0); PG8_MMA(1, 0, At, B0); PG8_BAR; PG8_SCHED;
            PG8_STAGE(PG8_SB(0, 1), b2 + hstep, voffB);
            PG8_WAIT_V(6); PG8_BAR; PG8_MMA(1, 1, At, B1); PG8_BAR;
            PG8_LDB(B0, 1, 0); PG8_SCHED; PG8_LDA(At, 1, 0); PG8_STAGE(PG8_SA(0, 1), a2 + hstep, voffA);
            PG8_WAIT_L(8); PG8_BAR; PG8_WAIT_L(0); PG8_MMA(0, 0, At, B0); PG8_BAR; PG8_SCHED;
            PG8_LDB(B1, 1, 1); PG8_STAGE(PG8_SB(1, 0), b3, voffB);
            PG8_BAR; PG8_WAIT_L(0); PG8_MMA(0, 1, At, B1); PG8_BAR;
            PG8_LDA(At, 1, 1); PG8_STAGE(PG8_SA(1, 0), a3, voffA);
            PG8_BAR; PG8_WAIT_L(0); PG8_MMA(1, 0, At, B0); PG8_BAR; PG8_SCHED;
            PG8_STAGE(PG8_SB(1, 1), b3 + hstep, voffB);
            PG8_WAIT_V(6); PG8_BAR; PG8_MMA(1, 1, At, B1); PG8_BAR;
            }
        }
        if constexpr (ALIGN_EPI) { if (wr == 0) PG8_BAR; }
        if constexpr (!Epi::AFTER_DRAIN) { E(acc, cur, wr, wc, fr, fq, lds + STAGE_BYTES + wid * 2048, lane); S.done(cur); }
        if (!has_next) break;
#pragma unroll
        for (int a = 0; a < 2; ++a)
#pragma unroll
            for (int b = 0; b < 2; ++b)
#pragma unroll
                for (int m = 0; m < 4; ++m)
#pragma unroll
                    for (int n = 0; n < 2; ++n) acc[a][b][m][n] = (f32x4){0.f, 0.f, 0.f, 0.f};
        cur = nxt; cA = nA; cB = nB; ++ui;
        if constexpr (ALIGN_EPI) { if (wr == 1) PG8_BAR; }
    }
    PG8_WAIT_V(0);
    if constexpr (!ALIGN_EPI) { if (wr == 0) PG8_BAR; }
    PG8_BAR;
    if constexpr (Epi::AFTER_DRAIN) { E.fused(acc, cur, wr, wc, fr, fq, lds, wid, lane); S.done(cur); }
#undef PG8_SA
#undef PG8_SB
#undef PG8_STAGE
#undef PG8_LDA
#undef PG8_LDB
#undef PG8_MMA
#undef PG8_WAIT_V
#undef PG8_WAIT_L
#undef PG8_BAR
#undef PG8_SCHED
}
}
constexpr int BATCH = 16, SEQ = 4096, DM = 1024, NH = 8, HD = 64, AW = 512, LW = 512, DFF = 2816, INW = 2568;
constexpr int M = BATCH * SEQ;
constexpr int NPROJ = 2560;
constexpr float NORM_EPS = 1e-6f, LOG2E = 1.4426950408889634f;
constexpr float QSCALE = 0.125f * 1.4426950408889634f;
constexpr int NWAVES = 8, NTHREADS = 512;
constexpr int LT = 64, NLT = SEQ / LT;

constexpr size_t MiB = 1u << 20;
constexpr size_t WS_W1 = 0;
constexpr size_t WS_WO = 6 * MiB;
constexpr size_t WS_WGU = 8 * MiB;
constexpr size_t WS_WD = 20 * MiB;
constexpr size_t WS_WG = 26 * MiB;
constexpr size_t WS_LOGF = 27 * MiB;
constexpr size_t WS_F = 29 * MiB;
constexpr size_t WS_AGGA = 31 * MiB, WS_AGGH = 33 * MiB;
constexpr size_t WS_HA = 36 * MiB;
constexpr size_t WS_Q = 164 * MiB;
constexpr size_t SZ_T = 64 * MiB;
constexpr size_t WS_ATT = WS_Q + 5 * SZ_T, WS_HL = WS_Q + 6 * SZ_T, WS_AC = WS_Q + 7 * SZ_T;
constexpr size_t WS_XB = WS_Q;
constexpr size_t WS_ACT = WS_Q + 2 * SZ_T;
constexpr size_t WS_BAR = 35 * MiB + 512 * 1024;
constexpr size_t WS_RSS = 35 * MiB;
constexpr size_t WS_MX = WS_Q + 8 * SZ_T;
constexpr size_t WS_END = WS_MX + 128 * MiB;
constexpr size_t WS_RS1 = 35 * MiB + 640 * 1024;
static_assert(WS_ACT + (size_t)M * DFF * 2 <= WS_END, "act overlay");

#define LAS __attribute__((address_space(3)))
typedef unsigned short bf16;
typedef unsigned u32x4 __attribute__((ext_vector_type(4)));
typedef unsigned u32x2 __attribute__((ext_vector_type(2)));
typedef float f32x4 __attribute__((ext_vector_type(4)));
typedef float f32x16 __attribute__((ext_vector_type(16)));
typedef short bf16x8 __attribute__((ext_vector_type(8)));
typedef short s16x4 __attribute__((ext_vector_type(4)));
__device__ __forceinline__ unsigned pk2(float lo, float hi) { return pg8::cvt_pk_bf16(lo, hi); }
__device__ __forceinline__ float bflo(unsigned w) { return __uint_as_float(w << 16); }
__device__ __forceinline__ float bfhi(unsigned w) { return __uint_as_float(w & 0xffff0000u); }
__device__ __forceinline__ float ex2(float x) { return __builtin_amdgcn_exp2f(x); }
__device__ __forceinline__ float wave_sum(float v) {
#pragma unroll
    for (int o = 1; o < 64; o <<= 1) v += __shfl_xor(v, o);
    return v;
}
__device__ __forceinline__ float sigmoidf_(float z) { return __builtin_amdgcn_rcpf(1.f + ex2(-z * LOG2E)); }

__device__ __forceinline__ void transpose_item(const float* src, int ldw, bf16* dst  , int K, LAS float* scr, int lane, const float* ksc = nullptr  ) {
    if ((ldw & 3) == 0 && (((size_t)src) & 15) == 0) {
        f32x4 v[8];
#pragma unroll
        for (int i = 0; i < 8; ++i) v[i] = *(const f32x4*)(src + (size_t)(8 * i + (lane >> 3)) * ldw + 4 * (lane & 7));
#pragma unroll
        for (int i = 0; i < 8; ++i) { const int kk = 8 * i + (lane >> 3); const float sc = ksc ? ksc[kk] : 1.f;
#pragma unroll
            for (int q = 0; q < 4; ++q) scr[kk * 33 + 4 * (lane & 7) + q] = v[i][q] * sc; }
    } else {
#pragma unroll 8
        for (int i = 0; i < 32; ++i) { const int kk = 2 * i + (lane >> 5); float v = src[(size_t)kk * ldw + (lane & 31)]; if (ksc) v *= ksc[kk]; scr[kk * 33 + (lane & 31)] = v; }
    }
    asm volatile("s_waitcnt lgkmcnt(0)" ::: "memory");
    const int c = lane & 7;
#pragma unroll
    for (int j = 0; j < 4; ++j) { const int n = (lane >> 3) + 8 * j; const LAS float* s = scr + (8 * c) * 33 + n;
        u32x4 o; o.x = pk2(s[0 * 33], s[1 * 33]); o.y = pk2(s[2 * 33], s[3 * 33]); o.z = pk2(s[4 * 33], s[5 * 33]); o.w = pk2(s[6 * 33], s[7 * 33]);
        *(u32x4*)(dst + (size_t)n * K + 8 * c) = o; }
    asm volatile("s_waitcnt lgkmcnt(0)" ::: "memory");
}

struct Params {
    const float* x; const float* norm1_g; const float* w_in; const float* q_g; const float* k_g; const float* b_f; const float* conv_w; const float* conv_b;
    const float* w_a; const float* b_a; const float* w_x; const float* b_x; const float* lam; const float* att_g; const float* lru_g; const float* w_out;
    const float* norm2_g; const float* w_gate; const float* w_up; const float* w_down;
    float* out; unsigned char* ws;
};

__device__ __forceinline__ void p0_weights(const Params& P, LAS unsigned char* lds, int gw, int ngw, int wave, int lane) {
    LAS float* scr = (LAS float*)(lds + wave * 8704);
    bf16* W1 = (bf16*)(P.ws + WS_W1); bf16* WO = (bf16*)(P.ws + WS_WO); bf16* WGU = (bf16*)(P.ws + WS_WGU); bf16* WD = (bf16*)(P.ws + WS_WD); bf16* WG = (bf16*)(P.ws + WS_WG);
    constexpr int I1 = 16 * (NPROJ / 32), I2 = 16 * (DM / 32), I3 = 16 * (2 * DFF / 32), I4 = (DFF / 64) * (DM / 32), I5 = 32;
    for (int it = gw; it < I1 + I2 + I3 + I4 + I5; it += ngw) {
        int r = it;
        if (r < I1) { const int nb = r % (NPROJ / 32), kb = r / (NPROJ / 32), n0 = nb * 32;
            const int pn = n0 >> 8, p = n0 & 255, bj = p >> 7, wc = (p >> 5) & 3; const int L = 256 * pn + 64 * wc + 32 * bj; const int sc = (L < 1536) ? L : L + 8;
            transpose_item(P.w_in + (size_t)(64 * kb) * INW + sc, INW, W1 + (size_t)n0 * DM + 64 * kb, DM, scr, lane, P.norm1_g + 64 * kb); continue; }
        r -= I1;
        if (r < I2) { const int nb = r % (DM / 32), kb = r / (DM / 32), n0 = nb * 32;
            const int pn = n0 >> 8, p = n0 & 255, bj = p >> 7, wc = (p >> 5) & 3; const int L = 256 * pn + 64 * wc + 32 * bj;
            transpose_item(P.w_out + (size_t)(64 * kb) * DM + L, DM, WO + (size_t)n0 * DM + 64 * kb, DM, scr, lane); continue; }
        r -= I2;
        if (r < I3) { const int nb = r % (2 * DFF / 32), kb = r / (2 * DFF / 32), n0 = nb * 32; const int pn = n0 >> 8, p = n0 & 255;
            const float* src = (p < 128) ? (P.w_gate + 128 * pn + p) : (P.w_up + 128 * pn + p - 128);
            transpose_item(src + (size_t)(64 * kb) * DFF, DFF, WGU + (size_t)n0 * DM + 64 * kb, DM, scr, lane, P.norm2_g + 64 * kb); continue; }
        r -= I3;
        if (r < I4) { const int nb = r % (DM / 32), kb = r / (DM / 32);
            transpose_item(P.w_down + (size_t)(64 * kb) * DM + 32 * nb, DM, WD + (size_t)(32 * nb) * DFF + 64 * kb, DFF, scr, lane); continue; }
        r -= I4;
        { const int gn = r >> 1, nb = r & 1; const float* src = ((gn < 8) ? P.w_a : P.w_x) + (size_t)(gn & 7) * 4096 + 32 * nb;
            transpose_item(src, 64, WG + (size_t)gn * 4096 + (size_t)(32 * nb) * 64, 64, scr, lane); }
    }
}

__device__ __forceinline__ void row_pass(const float* src, const float* g, bf16* dst, float* rs1, const float* w_in, const float* b_f, float* logf, int gw, int ngw, int lane) {
    f32x4 wf[4][4][2];
#pragma unroll
    for (int j = 0; j < 4; ++j) { const f32x4 gv = *(const f32x4*)(g + 4 * lane + 256 * j);
#pragma unroll
        for (int i = 0; i < 4; ++i) { const float* wp = w_in + (size_t)(256 * j + 4 * lane + i) * INW + 1536; wf[j][i][0] = *(const f32x4*)wp * gv[i]; wf[j][i][1] = *(const f32x4*)(wp + 4) * gv[i]; } }
    f32x4 nv[4];
    if (gw < M) {
#pragma unroll
        for (int j = 0; j < 4; ++j) nv[j] = __builtin_nontemporal_load((const f32x4*)(src + (size_t)gw * DM) + lane + 64 * j);
    }
    for (int m = gw; m < M; m += ngw) {
        f32x4 v[4]; float s = 0.f;
#pragma unroll
        for (int j = 0; j < 4; ++j) v[j] = nv[j];
        if (m + ngw < M) {
#pragma unroll
            for (int j = 0; j < 4; ++j) nv[j] = __builtin_nontemporal_load((const f32x4*)(src + (size_t)(m + ngw) * DM) + lane + 64 * j);
        }
        unsigned long long* o8 = (unsigned long long*)(dst + (size_t)m * DM) + lane;
#pragma unroll
        for (int j = 0; j < 4; ++j) o8[64 * j] = (unsigned long long)pk2(v[j][0], v[j][1]) | ((unsigned long long)pk2(v[j][2], v[j][3]) << 32);
#pragma unroll
        for (int j = 0; j < 4; ++j) s += (v[j][0] * v[j][0] + v[j][1] * v[j][1]) + (v[j][2] * v[j][2] + v[j][3] * v[j][3]);
        f32x4 a0 = {0.f, 0.f, 0.f, 0.f}, a1 = {0.f, 0.f, 0.f, 0.f};
#pragma unroll
        for (int j = 0; j < 4; ++j)
#pragma unroll
            for (int i = 0; i < 4; ++i) { a0 += wf[j][i][0] * v[j][i]; a1 += wf[j][i][1] * v[j][i]; }
        const float rs = rsqrtf(wave_sum(s) * (1.f / DM) + NORM_EPS);
        float z[8];
#pragma unroll
        for (int hh = 0; hh < 4; ++hh) { z[hh] = wave_sum(a0[hh]); z[4 + hh] = wave_sum(a1[hh]); }
        float zz = z[0];
#pragma unroll
        for (int hh = 1; hh < 8; ++hh) zz = (lane == hh) ? z[hh] : zz;
        if (lane < 8) { zz = zz * rs + b_f[lane]; const float lf = fminf(zz, 0.f) - log1pf(expf(-fabsf(zz)));
            const int b = m / SEQ, s_ = m % SEQ; logf[((size_t)(b * NH + lane)) * SEQ + s_] = lf; }
        if (lane == 8) rs1[m] = rs;
    }
}

__device__ __forceinline__ void cumsum_seq(const float* logf, float* F, int seq, int lane) {
    const f32x4* src = (const f32x4*)(logf + (size_t)seq * SEQ + 64 * lane);
    f32x4 v[16]; float s = 0.f;
#pragma unroll
    for (int i = 0; i < 16; ++i) { v[i] = src[i]; s += (v[i][0] + v[i][1]) + (v[i][2] + v[i][3]); }
    float inc = s;
#pragma unroll
    for (int o = 1; o < 64; o <<= 1) { const float t = __shfl_up(inc, o); if (lane >= o) inc += t; }
    float run = inc - s;
    f32x4* dst = (f32x4*)(F + (size_t)seq * SEQ + 64 * lane);
#pragma unroll
    for (int i = 0; i < 16; ++i) { f32x4 o; run += v[i][0]; o[0] = run; run += v[i][1]; o[1] = run; run += v[i][2]; o[2] = run; run += v[i][3]; o[3] = run; dst[i] = o; }
}

__device__ __forceinline__ void lru_unit(const Params& P, int b, int c, LAS unsigned char* lds, int wave, int lane) {
    const int fr = lane & 15, fq = lane >> 4;
    const bf16* LX = (const bf16*)(P.ws + WS_Q + 3 * SZ_T);
    const bf16* WG = (const bf16*)(P.ws + WS_WG);
    unsigned* HLAC = (unsigned*)(P.ws + WS_HL);
    LAS unsigned char* stg = lds + wave * (64 * 272);
    float* AGGA = (float*)(P.ws + WS_AGGA); float* AGGH = (float*)(P.ws + WS_AGGH);
    const size_t rowbase = (size_t)b * SEQ; const int tb = c * LT;
    float ba[4], bx[4], c8[4];
#pragma unroll
    for (int nn = 0; nn < 4; ++nn) { const int e = 64 * wave + 16 * nn + fr; ba[nn] = P.b_a[e]; bx[nn] = P.b_x[e]; c8[nn] = P.lam[e]; }
    bf16x8 wan[2], wxn[2];
#pragma unroll
    for (int kk = 0; kk < 2; ++kk) { wan[kk] = *(const bf16x8*)(WG + ((size_t)(wave) * 64 + fr) * 64 + 32 * kk + 8 * fq); wxn[kk] = *(const bf16x8*)(WG + ((size_t)(8 + wave) * 64 + fr) * 64 + 32 * kk + 8 * fq); }
    {
        u32x4 lr[9];
#pragma unroll
        for (int i = 0; i < 9; ++i) { const int row = 8 * i + (lane >> 3); const int tt = tb + row - 3; lr[i] = (u32x4){0u, 0u, 0u, 0u};
            if (row < 67 && tt >= 0) lr[i] = __builtin_nontemporal_load((const u32x4*)(LX + (rowbase + tt) * LW + 64 * wave + 8 * (lane & 7))); }
#pragma unroll
        for (int i = 0; i < 9; ++i) { const int row = 8 * i + (lane >> 3); *(LAS u32x4*)(stg + row * 144 + (lane & 7) * 16) = lr[i]; }
    }
    bf16x8 xa[4][2];
#pragma unroll
    for (int kk = 0; kk < 2; ++kk) {
        const int ch0 = 64 * wave + 32 * kk + 8 * fq;
        f32x4 cw[4][2], cb[2];
#pragma unroll
        for (int j = 0; j < 4; ++j) { cw[j][0] = *(const f32x4*)(P.conv_w + j * LW + ch0); cw[j][1] = *(const f32x4*)(P.conv_w + j * LW + ch0 + 4); }
        cb[0] = *(const f32x4*)(P.conv_b + ch0); cb[1] = *(const f32x4*)(P.conv_b + ch0 + 4);
#pragma unroll
        for (int m = 0; m < 4; ++m) {
            const int tl = 16 * (fr >> 2) + 4 * m + (fr & 3);
            u32x4 w[4];
#pragma unroll
            for (int j = 0; j < 4; ++j) w[j] = *(const LAS u32x4*)(stg + (tl + j) * 144 + (32 * kk + 8 * fq) * 2);
            f32x4 a0 = cb[0], a1 = cb[1];
#pragma unroll
            for (int j = 0; j < 4; ++j) {
                a0[0] += bflo(w[j].x) * cw[j][0][0]; a0[1] += bfhi(w[j].x) * cw[j][0][1]; a0[2] += bflo(w[j].y) * cw[j][0][2]; a0[3] += bfhi(w[j].y) * cw[j][0][3];
                a1[0] += bflo(w[j].z) * cw[j][1][0]; a1[1] += bfhi(w[j].z) * cw[j][1][1]; a1[2] += bflo(w[j].w) * cw[j][1][2]; a1[3] += bfhi(w[j].w) * cw[j][1][3]; }
            u32x4 pk; pk.x = pk2(a0[0], a0[1]); pk.y = pk2(a0[2], a0[3]); pk.z = pk2(a1[0], a1[1]); pk.w = pk2(a1[2], a1[3]);
            xa[m][kk] = __builtin_bit_cast(bf16x8, pk);
        }
    }
#pragma unroll
    for (int nn = 0; nn < 4; ++nn) c8[nn] = 8.f * (fmaxf(-c8[nn], 0.f) + log1pf(expf(-fabsf(c8[nn]))));
#pragma unroll
    for (int nn = 0; nn < 4; ++nn) {
        asm volatile("" ::: "memory");
        const int e = 64 * wave + 16 * nn + fr;
        bf16x8 wa[2], wx[2];
#pragma unroll
        for (int kk = 0; kk < 2; ++kk) { wa[kk] = wan[kk]; wx[kk] = wxn[kk]; }
        if (nn < 3) {
#pragma unroll
            for (int kk = 0; kk < 2; ++kk) { wan[kk] = *(const bf16x8*)(WG + ((size_t)(wave) * 64 + 16 * (nn + 1) + fr) * 64 + 32 * kk + 8 * fq); wxn[kk] = *(const bf16x8*)(WG + ((size_t)(8 + wave) * 64 + 16 * (nn + 1) + fr) * 64 + 32 * kk + 8 * fq); }
        }
        bf16x8 idm[2];
#pragma unroll
        for (int kk = 0; kk < 2; ++kk) {
            const int idx = 16 * nn + fr - 32 * kk - 8 * fq;
            bf16x8 t;
#pragma unroll
            for (int i = 0; i < 8; ++i) t[i] = (idx == i) ? (short)0x3F80 : (short)0;
            idm[kk] = t;
        }
        float hl[16], al[16]; float H = 0.f, A = 1.f;
#pragma unroll
        for (int m = 0; m < 4; ++m) {
            f32x4 ga = {0.f, 0.f, 0.f, 0.f}, gx = ga, xc = ga;
#pragma unroll
            for (int kk = 0; kk < 2; ++kk) {
                ga = __builtin_amdgcn_mfma_f32_16x16x32_bf16(xa[m][kk], wa[kk], ga, 0, 0, 0);
                gx = __builtin_amdgcn_mfma_f32_16x16x32_bf16(xa[m][kk], wx[kk], gx, 0, 0, 0);
                xc = __builtin_amdgcn_mfma_f32_16x16x32_bf16(xa[m][kk], idm[kk], xc, 0, 0, 0);
            }
#pragma unroll
            for (int jj = 0; jj < 4; ++jj) {
                const float r = sigmoidf_(ga[jj] + ba[nn]), ig = sigmoidf_(gx[jj] + bx[nn]);
                const float la = -c8[nn] * r;
                const float a = ex2(la * LOG2E);
                const float t2 = 2.f * la;
                const float om = (t2 > -0.004f) ? -t2 * (1.f + 0.5f * t2) : (1.f - a * a);
                const float uu = __builtin_amdgcn_sqrtf(om) * (ig * xc[jj]);
                A *= a; H = a * H + uu; hl[4 * m + jj] = H; al[4 * m + jj] = A;
            }
        }
        float Ai = A, Hi = H;
        { const float Ap = __shfl_up(Ai, 16), Hp = __shfl_up(Hi, 16); if (fq >= 1) { Hi = Ai * Hp + Hi; Ai = Ai * Ap; } }
        { const float Ap = __shfl_up(Ai, 32), Hp = __shfl_up(Hi, 32); if (fq >= 2) { Hi = Ai * Hp + Hi; Ai = Ai * Ap; } }
        float Pin = __shfl_up(Ai, 16), Hin = __shfl_up(Hi, 16); if (fq == 0) { Pin = 1.f; Hin = 0.f; }
#pragma unroll
        for (int k = 0; k < 16; ++k) {
            const float hv = hl[k] + al[k] * Hin, av = al[k] * Pin;
            *(LAS unsigned*)(stg + (16 * fq + k) * 272 + (16 * nn + fr) * 4) = pk2(hv, av);
        }
        if (fq == 3) { const size_t ao = ((size_t)b * NLT + c) * LW + e; AGGA[ao] = Ai; AGGH[ao] = Hi; }
    }
#pragma unroll 4
    for (int k = 0; k < 16; ++k) { const int row = 4 * k + (lane >> 4), ch = lane & 15;
        const u32x4 w = *(const LAS u32x4*)(stg + row * 272 + ch * 16);
        __builtin_nontemporal_store(w, (u32x4*)(HLAC + (rowbase + tb + row) * LW + 64 * wave + 4 * ch)); }
}

namespace att {
constexpr int KST = 144, VST = 192, KB = 64 * KST, VB = 64 * VST, BUF = KB + VB + 256;
constexpr int OST = 2 * BUF, OSTW = 32 * 144;
typedef short v4i16_t __attribute__((ext_vector_type(4)));
__device__ __forceinline__ s16x4 vtr(const LAS unsigned char* p) { return __builtin_bit_cast(s16x4, __builtin_amdgcn_ds_read_tr16_b64_v4i16((LAS v4i16_t*)p)); }
__device__ __forceinline__ float max3f(float a, float b, float c) { float r; asm("v_max3_f32 %0, %1, %2, %3" : "=v"(r) : "v"(a), "v"(b), "v"(c)); return r; }
struct TileRegs { u32x4 k, v; float f; };
struct UnitPre { bf16x8 qf[4]; float Fref, Fend; TileRegs t; };
__device__ __forceinline__ void unit_of(int i, int G, int& b, int& h, int& qb) { const int rest = i >> 4, r = i & 15; qb = ((i / G) & 1) ? r : 15 - r; b = rest & 15; h = rest >> 4; }
__device__ __forceinline__ TileRegs load_tile(const bf16* kg, const bf16* vg, const float* F, int j, int tid) {
    TileRegs t; t.k = *(const u32x4*)(kg + (size_t)(64 * j) * AW); t.v = *(const u32x4*)(vg + (size_t)(64 * j) * AW); t.f = 0.f; if (tid < 64) t.f = F[64 * j + tid]; return t; }
__device__ __forceinline__ void store_tile(LAS unsigned char* bb, const TileRegs& t, float Fref, int krow, int kch, int tid) {
    *(LAS u32x4*)(bb + krow * KST + kch * 16) = t.k; *(LAS u32x4*)(bb + KB + krow * VST + kch * 16) = t.v; if (tid < 64) ((LAS float*)(bb + KB + VB))[tid] = (Fref - t.f) * LOG2E; }
__device__ __forceinline__ UnitPre prefetch_unit(const Params& P, int b, int h, int qb, int tid, int wave, int lane) {
    UnitPre u; const int r32 = lane & 31, hi = lane >> 5, t0 = qb * 256, NT = (t0 + 256) / 64; const size_t rowbase = (size_t)b * SEQ;
    const bf16* Q = (const bf16*)(P.ws + WS_Q); const bf16* K = (const bf16*)(P.ws + WS_Q + SZ_T); const bf16* V = (const bf16*)(P.ws + WS_Q + 2 * SZ_T);
    const float* F = (const float*)(P.ws + WS_F) + ((size_t)b * NH + h) * SEQ;
    const bf16* qp = Q + (rowbase + t0 + 32 * wave + r32) * AW + h * HD + 8 * hi;
#pragma unroll
    for (int ds = 0; ds < 4; ++ds) u.qf[ds] = __builtin_nontemporal_load((const bf16x8*)(qp + 16 * ds));
    u.Fref = F[t0]; const int jl = (lane < NT) ? lane : (NT - 1); u.Fend = F[64 * jl + 63];
    const int krow = tid >> 3, kch = tid & 7;
    u.t = load_tile(K + (rowbase + krow) * AW + h * HD + kch * 8, V + (rowbase + krow) * AW + h * HD + kch * 8, F, NT - 1, tid);
    return u;
}
__device__ __forceinline__ void attn_phase(const Params& P, LAS unsigned char* lds, int bx, int G, int tid, int wave, int lane, float skip_thr) {
    const int r32 = lane & 31, hi = lane >> 5, krow = tid >> 3, kch = tid & 7;
    const int NU = BATCH * NH * 16;
    const int pr = (r32 & ~12) | ((r32 & 4) << 1) | ((r32 & 8) >> 1);
    const int koff = pr * KST + 16 * hi;
    const int voff = (8 * hi + ((lane & 15) >> 2)) * VST + (16 * ((lane >> 4) & 1) + 4 * (lane & 3)) * 2;
    if (bx >= NU) return;
    int b, h, qb; unit_of(bx, G, b, h, qb);
    UnitPre pre = prefetch_unit(P, b, h, qb, tid, wave, lane);
    for (int i = bx; i < NU; i += G) {
        const bf16* K = (const bf16*)(P.ws + WS_Q + SZ_T); const bf16* V = (const bf16*)(P.ws + WS_Q + 2 * SZ_T);
        bf16* O = (bf16*)(P.ws + WS_ATT); const float* F = (const float*)(P.ws + WS_F) + ((size_t)b * NH + h) * SEQ;
        const size_t rowbase = (size_t)b * SEQ; const int t0 = qb * 256;
        const int qpos = t0 + 32 * wave + r32;
        const int NT = (t0 + 256) / 64;
        bf16x8 qf[4];
#pragma unroll
        for (int ds = 0; ds < 4; ++ds) qf[ds] = pre.qf[ds];
        const float Fref = pre.Fref;
        int j0;
        {
            const float bl = (Fref - pre.Fend) * LOG2E;
            const unsigned long long mk = __ballot((lane < NT) && (bl >= skip_thr));
            j0 = mk ? (int)__builtin_ctzll(mk) : (NT - 1);
            j0 = __builtin_amdgcn_readfirstlane(j0);
            if (j0 > NT - 4) j0 = NT - 4;
        }
        const bf16* kg = K + (rowbase + krow) * AW + h * HD + kch * 8;
        const bf16* vg = V + (rowbase + krow) * AW + h * HD + kch * 8;
        store_tile(lds, pre.t, Fref, krow, kch, tid);
        TileRegs n1 = load_tile(kg, vg, F, NT - 2, tid);
        __syncthreads();
        int nb = b, nh = h, nqb = qb;
        if (i + G < NU) { unit_of(i + G, G, nb, nh, nqb); pre = prefetch_unit(P, nb, nh, nqb, tid, wave, lane); }
        f32x16 o0 = {}, o1 = {}; float mrun = -1e30f, lrun = 0.f;
        for (int j = NT - 1; j >= j0; --j) {
            const int cur = (NT - 1 - j) & 1;
            TileRegs n2 = n1;
            if (j - 2 >= j0) n2 = load_tile(kg, vg, F, j - 2, tid);
            if (64 * j <= t0 + 32 * wave) {
                const LAS unsigned char* bb = lds + cur * BUF;
                const LAS float* Bl = (const LAS float*)(bb + KB + VB);
                f32x16 p0, p1;
#pragma unroll
                for (int g = 0; g < 4; ++g) { const f32x4 t = *(const LAS f32x4*)(Bl + 8 * hi + 16 * (g >> 1) + 4 * (g & 1)); const f32x4 u = *(const LAS f32x4*)(Bl + 32 + 8 * hi + 16 * (g >> 1) + 4 * (g & 1));
#pragma unroll
                    for (int q = 0; q < 4; ++q) { p0[4 * g + q] = t[q]; p1[4 * g + q] = u[q]; } }
#pragma unroll
                for (int ds = 0; ds < 4; ++ds) {
                    const bf16x8 k0 = *(const LAS bf16x8*)(bb + koff + 32 * ds), k1 = *(const LAS bf16x8*)(bb + koff + 32 * KST + 32 * ds);
                    p0 = __builtin_amdgcn_mfma_f32_32x32x16_bf16(k0, qf[ds], p0, 0, 0, 0);
                    p1 = __builtin_amdgcn_mfma_f32_32x32x16_bf16(k1, qf[ds], p1, 0, 0, 0);
                }
                if (64 * j + 63 > t0 + 32 * wave) {
                    const int kq = qpos - 64 * j;
#pragma unroll
                    for (int jj = 0; jj < 16; ++jj) { const int kl = 8 * hi + (jj & 7) + 16 * (jj >> 3); if (kl > kq) p0[jj] = -INFINITY; if (kl + 32 > kq) p1[jj] = -INFINITY; }
                }
                float ma = max3f(p0[0], p0[1], p1[0]), mb = max3f(p0[2], p0[3], p1[1]); ma = max3f(ma, p1[2], p1[3]);
#pragma unroll
                for (int jj = 4; jj < 16; jj += 4) { ma = max3f(ma, p0[jj], p0[jj + 1]); mb = max3f(mb, p0[jj + 2], p0[jj + 3]); ma = max3f(ma, p1[jj], p1[jj + 1]); mb = max3f(mb, p1[jj + 2], p1[jj + 3]); }
                float mx = max3f(ma, mb, mb);
                mx = max3f(mx, __shfl_xor(mx, 32), mx);
                if (__any(mx > mrun + 8.f)) {
                    const float mnew = max3f(mrun, mx, mx), alpha = ex2(mrun - mnew);
                    mrun = mnew; lrun *= alpha;
#pragma unroll
                    for (int jj = 0; jj < 16; ++jj) { o0[jj] *= alpha; o1[jj] *= alpha; }
                }
                p0 = p0 - mrun; p1 = p1 - mrun;
#pragma unroll
                for (int jj = 0; jj < 16; ++jj) { p0[jj] = ex2(p0[jj]); p1[jj] = ex2(p1[jj]); }
                { const f32x16 sv = p0 + p1; const f32x4 s4 = (f32x4){sv[0], sv[1], sv[2], sv[3]} + (f32x4){sv[4], sv[5], sv[6], sv[7]} + (f32x4){sv[8], sv[9], sv[10], sv[11]} + (f32x4){sv[12], sv[13], sv[14], sv[15]};
                  lrun += (s4[0] + s4[1]) + (s4[2] + s4[3]); }
                bf16x8 pb[4];
#pragma unroll
                for (int c = 0; c < 4; ++c) { u32x4 w;
                    if (c < 2) { w.x = pk2(p0[8 * c], p0[8 * c + 1]); w.y = pk2(p0[8 * c + 2], p0[8 * c + 3]); w.z = pk2(p0[8 * c + 4], p0[8 * c + 5]); w.w = pk2(p0[8 * c + 6], p0[8 * c + 7]); }
                    else { const int c2 = c - 2; w.x = pk2(p1[8 * c2], p1[8 * c2 + 1]); w.y = pk2(p1[8 * c2 + 2], p1[8 * c2 + 3]); w.z = pk2(p1[8 * c2 + 4], p1[8 * c2 + 5]); w.w = pk2(p1[8 * c2 + 6], p1[8 * c2 + 7]); }
                    pb[c] = __builtin_bit_cast(bf16x8, w); }
                const LAS unsigned char* vb = bb + KB + voff;
#pragma unroll
                for (int c = 0; c < 4; ++c) {
                    const s16x4 a0 = vtr(vb + (16 * c) * VST), a1 = vtr(vb + (16 * c + 4) * VST);
                    const s16x4 b0 = vtr(vb + (16 * c) * VST + 64), b1 = vtr(vb + (16 * c + 4) * VST + 64);
                    const bf16x8 va = {a0[0], a0[1], a0[2], a0[3], a1[0], a1[1], a1[2], a1[3]};
                    const bf16x8 vb2 = {b0[0], b0[1], b0[2], b0[3], b1[0], b1[1], b1[2], b1[3]};
                    o0 = __builtin_amdgcn_mfma_f32_32x32x16_bf16(va, pb[c], o0, 0, 0, 0);
                    o1 = __builtin_amdgcn_mfma_f32_32x32x16_bf16(vb2, pb[c], o1, 0, 0, 0);
                }
            }
            if (j > j0) store_tile(lds + (cur ^ 1) * BUF, n1, Fref, krow, kch, tid);
            n1 = n2;
            __syncthreads();
        }
        const float lt = lrun + __shfl_xor(lrun, 32);
        const float inv = 1.f / lt;
        LAS unsigned char* stg = lds + OST + wave * OSTW;
#pragma unroll
        for (int g = 0; g < 4; ++g) {
            u32x2 w0, w1;
            w0.x = pk2(o0[4 * g] * inv, o0[4 * g + 1] * inv); w0.y = pk2(o0[4 * g + 2] * inv, o0[4 * g + 3] * inv);
            w1.x = pk2(o1[4 * g] * inv, o1[4 * g + 1] * inv); w1.y = pk2(o1[4 * g + 2] * inv, o1[4 * g + 3] * inv);
            *(LAS u32x2*)(stg + r32 * 144 + (8 * g + 4 * hi) * 2) = w0; *(LAS u32x2*)(stg + r32 * 144 + (32 + 8 * g + 4 * hi) * 2) = w1;
        }
        bf16* ow = O + (rowbase + t0 + 32 * wave) * AW + h * HD;
#pragma unroll
        for (int q = 0; q < 4; ++q) { const int row = 8 * q + (lane >> 3), ch = lane & 7;
            const u32x4 v = *(const LAS u32x4*)(stg + row * 144 + ch * 16);
            __builtin_nontemporal_store(v, (u32x4*)(ow + (size_t)row * AW + ch * 8)); }
        b = nb; h = nh; qb = nqb;
    }
}
}

__device__ __forceinline__ void mix_superunit(const Params& P, int su, LAS unsigned char* lds, int tid, int wave, int lane) {
    const int b = su >> 4, c0 = 4 * (su & 15);
    const bf16* ATT = (const bf16*)(P.ws + WS_ATT); const unsigned* HLAC = (const unsigned*)(P.ws + WS_HL);
    const bf16* LG = (const bf16*)(P.ws + WS_Q + 4 * SZ_T); bf16* MX = (bf16*)(P.ws + WS_MX);
    const float* AGGA = (const float*)(P.ws + WS_AGGA) + (size_t)b * NLT * LW + tid; const float* AGGH = (const float*)(P.ws + WS_AGGH) + (size_t)b * NLT * LW + tid;
    LAS float* carr = (LAS float*)lds;
    float carry = 0.f;
    {
        int c = 0;
        for (; c + 8 <= c0; c += 8) { float a[8], h[8];
#pragma unroll
            for (int i = 0; i < 8; ++i) { a[i] = AGGA[(c + i) * LW]; h[i] = AGGH[(c + i) * LW]; }
#pragma unroll
            for (int i = 0; i < 8; ++i) carry = h[i] + a[i] * carry; }
        if (c < c0) { float a[4], h[4];
#pragma unroll
            for (int i = 0; i < 4; ++i) { a[i] = AGGA[(c + i) * LW]; h[i] = AGGH[(c + i) * LW]; }
#pragma unroll
            for (int i = 0; i < 4; ++i) carry = h[i] + a[i] * carry; }
    }
    f32x4 ga[2], gr[2];
    ga[0] = *(const f32x4*)(P.att_g + 8 * lane); ga[1] = *(const f32x4*)(P.att_g + 8 * lane + 4);
    gr[0] = *(const f32x4*)(P.lru_g + 8 * lane); gr[1] = *(const f32x4*)(P.lru_g + 8 * lane + 4);
    for (int cc = 0; cc < 4; ++cc) {
        const int c = c0 + cc;
        const float nA = AGGA[c * LW], nH = AGGH[c * LW];
        carr[tid] = carry; __syncthreads();
        const f32x4 cr0 = *(const LAS f32x4*)(carr + 8 * lane), cr1 = *(const LAS f32x4*)(carr + 8 * lane + 4);
        const float crv[8] = {cr0[0], cr0[1], cr0[2], cr0[3], cr1[0], cr1[1], cr1[2], cr1[3]};
#pragma unroll 1
        for (int rg = 0; rg < 2; ++rg) {
            u32x4 wa[4], wg[4], wp[4][2];
#pragma unroll
            for (int r = 0; r < 4; ++r) { const size_t row = (size_t)b * SEQ + c * LT + 8 * wave + 4 * rg + r;
                wa[r] = __builtin_nontemporal_load((const u32x4*)(ATT + row * AW + 8 * lane)); wg[r] = __builtin_nontemporal_load((const u32x4*)(LG + row * LW + 8 * lane));
                wp[r][0] = __builtin_nontemporal_load((const u32x4*)(HLAC + row * LW + 8 * lane)); wp[r][1] = __builtin_nontemporal_load((const u32x4*)(HLAC + row * LW + 8 * lane + 4)); }
#pragma unroll
            for (int r = 0; r < 4; ++r) { const size_t row = (size_t)b * SEQ + c * LT + 8 * wave + 4 * rg + r;
                float av[8], rv[8];
#pragma unroll
                for (int i = 0; i < 4; ++i) { av[2 * i] = bflo(wa[r][i]); av[2 * i + 1] = bfhi(wa[r][i]);
                    const unsigned p0 = wp[r][i >> 1][2 * (i & 1)], p1 = wp[r][i >> 1][2 * (i & 1) + 1];
                    const float h0 = bflo(p0) + bfhi(p0) * crv[2 * i], h1 = bflo(p1) + bfhi(p1) * crv[2 * i + 1];
                    const float g0 = bflo(wg[r][i]), g1 = bfhi(wg[r][i]);
                    const float y0 = 0.7978845608f * (g0 + 0.044715f * g0 * g0 * g0), y1 = 0.7978845608f * (g1 + 0.044715f * g1 * g1 * g1);
                    rv[2 * i] = h0 * g0 * sigmoidf_(2.f * y0); rv[2 * i + 1] = h1 * g1 * sigmoidf_(2.f * y1); }
                float sa = 0.f, sr = 0.f;
#pragma unroll
                for (int i = 0; i < 8; ++i) { sa += av[i] * av[i]; sr += rv[i] * rv[i]; }
                sa = wave_sum(sa); sr = wave_sum(sr);
                const float ra = rsqrtf(sa * (1.f / AW) + NORM_EPS), rr = rsqrtf(sr * (1.f / LW) + NORM_EPS);
                u32x4 oa, orr;
                oa.x = pk2(av[0] * ra * ga[0][0], av[1] * ra * ga[0][1]); oa.y = pk2(av[2] * ra * ga[0][2], av[3] * ra * ga[0][3]);
                oa.z = pk2(av[4] * ra * ga[1][0], av[5] * ra * ga[1][1]); oa.w = pk2(av[6] * ra * ga[1][2], av[7] * ra * ga[1][3]);
                orr.x = pk2(rv[0] * rr * gr[0][0], rv[1] * rr * gr[0][1]); orr.y = pk2(rv[2] * rr * gr[0][2], rv[3] * rr * gr[0][3]);
                orr.z = pk2(rv[4] * rr * gr[1][0], rv[5] * rr * gr[1][1]); orr.w = pk2(rv[6] * rr * gr[1][2], rv[7] * rr * gr[1][3]);
                *(u32x4*)(MX + row * DM + 8 * lane) = oa; *(u32x4*)(MX + row * DM + AW + 8 * lane) = orr;
            }
        }
        carry = nH + nA * carry;
        __syncthreads();
    }
}

#define XB_TMO      128
#define XB_XCNT(j)  (256  + 64 * (j))
#define XB_XSUB(j)  (1280 + 64 * (j))
#define XB_XGEN(j)  (2304 + 64 * (j))
#define XB_TOP      3328
#define XB_TOPGEN   3392
#define XCD_BAR_WORDS 3456
#define XB_SPIN_CAP (1u << 18)

__device__ __forceinline__ unsigned xb_ld(unsigned* p)              { return __hip_atomic_load(p, __ATOMIC_RELAXED, __HIP_MEMORY_SCOPE_AGENT); }
__device__ __forceinline__ unsigned xb_add(unsigned* p, unsigned v) { return __hip_atomic_fetch_add(p, v, __ATOMIC_RELAXED, __HIP_MEMORY_SCOPE_AGENT); }
__device__ __forceinline__ unsigned xb_xcc_id() { return (unsigned)__builtin_amdgcn_s_getreg((3 << 11) | 20) & 0xFu; }
#define XB_SPIN(cond, bar) do { unsigned _sp = 0; while (cond) { __builtin_amdgcn_s_sleep(1); \
    if ((++_sp & 255u) == 0u) { if (xb_ld(&(bar)[XB_TMO])) break; if (_sp > XB_SPIN_CAP) { atomicAdd(&(bar)[XB_TMO], 1u); break; } } } } while (0)

struct XcdBarrier {
    unsigned* bar; unsigned x;
    volatile LAS unsigned* st;
};

__device__ __forceinline__ XcdBarrier xcd_barrier_post(unsigned* bar, volatile LAS unsigned* st) {
    XcdBarrier b; b.bar = bar; b.x = xb_xcc_id(); b.st = st;
    if (threadIdx.x == 0) (void)xb_add(&bar[XB_XCNT(b.x)], 1u);
    return b;
}
__device__ __forceinline__ void xcd_barrier_complete(unsigned* bar, unsigned x, unsigned& nloc, unsigned& nx) {
    const unsigned G = gridDim.x * gridDim.y * gridDim.z;
    unsigned sum, cnt, mine, sp = 0u;
    for (;;) {
        sum = 0u; cnt = 0u; mine = 0u;
#pragma unroll
        for (unsigned j = 0; j < 16; ++j) { const unsigned c = xb_ld(&bar[XB_XCNT(j)]); sum += c; cnt += (c > 0u) ? 1u : 0u; mine = (j == x) ? c : mine; }
        if (sum == G) break;
        __builtin_amdgcn_s_sleep(1);
        if ((++sp & 255u) == 0u) { if (xb_ld(&bar[XB_TMO])) break; if (sp > XB_SPIN_CAP) { atomicAdd(&bar[XB_TMO], 1u); break; } }
    }
    nloc = mine > 0u ? mine : 1u; nx = cnt > 0u ? cnt : 1u;
}

__device__ __forceinline__ void xcd_barrier(const XcdBarrier& b) {
    asm volatile("s_waitcnt vmcnt(0)" ::: "memory");
    __syncthreads();
    if (threadIdx.x == 0) {
        unsigned* bar = b.bar;
        __builtin_amdgcn_s_waitcnt(0);
        unsigned nloc = b.st[0], nx = b.st[1];
        if (nloc == 0u) { xcd_barrier_complete(bar, b.x, nloc, nx); b.st[0] = nloc; b.st[1] = nx; }
        const unsigned old = xb_add(&bar[XB_XSUB(b.x)], 1u);
        const unsigned gen = old / nloc;
        if (old + 1u == (gen + 1u) * nloc) {
            __builtin_amdgcn_fence(__ATOMIC_RELEASE, "agent");
            asm volatile("s_waitcnt vmcnt(0)" ::: "memory");
            const unsigned og = xb_add(&bar[XB_TOP], 1u);
            const unsigned tg = og / nx;
            if (og + 1u == (tg + 1u) * nx) xb_add(&bar[XB_TOPGEN], 1u);
            else XB_SPIN(xb_ld(&bar[XB_TOPGEN]) == tg, bar);
            __builtin_amdgcn_fence(__ATOMIC_ACQUIRE, "agent");
            xb_add(&bar[XB_XGEN(b.x)], 1u);
            asm volatile("s_waitcnt vmcnt(0)" ::: "memory");
        } else {
            XB_SPIN(xb_ld(&bar[XB_XGEN(b.x)]) == gen, bar);
            __builtin_amdgcn_fence(__ATOMIC_ACQUIRE, "agent");
            asm volatile("s_waitcnt vmcnt(0)" ::: "memory");
        }
    }
    __syncthreads();
}

#ifndef REP_P0
#define REP_P0 1
#endif
#ifndef REP_LRU
#define REP_LRU 1
#endif
#ifndef REP_ATT
#define REP_ATT 1
#endif
#ifndef REP_MIX
#define REP_MIX 1
#endif
#ifndef REP_G4
#define REP_G4 1
#endif
constexpr int LDS_BARST = 147456;
constexpr int LDS_BYTES = 147456 + 256;
__global__ void __launch_bounds__(NTHREADS) hymba_fwd(Params P) {
    extern __shared__ __attribute__((aligned(16))) unsigned char lds_raw[];
    LAS unsigned char* lds = (LAS unsigned char*)lds_raw;
    cg::grid_group grid = cg::this_grid();
    const int tid = threadIdx.x, lane = tid & 63, wave = __builtin_amdgcn_readfirstlane(tid >> 6);
    const int G = gridDim.x, bx = blockIdx.x;
    const int gw = bx * NWAVES + wave, ngw = G * NWAVES;
    bf16* HA = (bf16*)(P.ws + WS_HA);
    volatile LAS unsigned* barst = (volatile LAS unsigned*)(lds + LDS_BARST);
    if (tid < 2) barst[tid] = 0u;
    if (bx == 0) for (int i = tid; i < XCD_BAR_WORDS; i += NTHREADS) ((unsigned*)(P.ws + WS_BAR))[i] = 0u;
    __syncthreads();
    grid.sync();
    const XcdBarrier xbar = xcd_barrier_post((unsigned*)(P.ws + WS_BAR), barst);

    p0_weights(P, lds, gw, ngw, wave, lane);
    for (int i = bx * NTHREADS + tid; i < M; i += G * NTHREADS) ((float*)(P.ws + WS_RSS))[i] = 0.f;
    for (int rep = 0; rep < REP_P0; ++rep) row_pass(P.x, P.norm1_g, HA, (float*)(P.ws + WS_RS1), P.w_in, P.b_f, (float*)(P.ws + WS_LOGF), gw, ngw, lane);
    xcd_barrier(xbar);

    if (wave == 0) for (int s = bx; s < BATCH * NH; s += G) cumsum_seq((const float*)(P.ws + WS_LOGF), (float*)(P.ws + WS_F), s, lane);
    {
        pg8::Gemm g{HA, (const pg8::bf16_t*)(P.ws + WS_W1), M, NPROJ, DM}; pg8::StaticOrder S; S.init(M, NPROJ, G, bx);
        pg8::EpiProj E{(pg8::bf16_t*)(P.ws + WS_Q), SZ_T / 2, P.q_g, P.k_g, QSCALE, (const float*)(P.ws + WS_RS1)};
        pg8::gemm_phase<pg8::EpiProj, pg8::StaticOrder, true, true>(lds, g, S, E);
    }
    xcd_barrier(xbar);

    for (int rep = 0; rep < REP_LRU; ++rep) for (int u = bx; u < BATCH * NLT; u += G) lru_unit(P, u / NLT, u % NLT, lds, wave, lane);
    __syncthreads();
    {
        float gqm = 0.f, gkm = 0.f;
        gqm = fabsf(P.q_g[lane]); gkm = fabsf(P.k_g[lane]);
#pragma unroll
        for (int o = 1; o < 64; o <<= 1) { gqm = fmaxf(gqm, __shfl_xor(gqm, o)); gkm = fmaxf(gkm, __shfl_xor(gkm, o)); }
        const float skip_thr = -(2.f * 1.05f * 8.f * gqm * gkm * LOG2E + 40.f);
        for (int rep = 0; rep < REP_ATT; ++rep) att::attn_phase(P, lds, bx, G, tid, wave, lane, skip_thr);
    }
    xcd_barrier(xbar);

    for (int rep = 0; rep < REP_MIX; ++rep) for (int su = bx; su < BATCH * 16; su += G) mix_superunit(P, su, lds, tid, wave, lane);
    xcd_barrier(xbar);

    {
        pg8::Gemm g{(const pg8::bf16_t*)(P.ws + WS_MX), (const pg8::bf16_t*)(P.ws + WS_WO), M, DM, DM}; pg8::StaticOrder S; S.init(M, DM, G, bx);
        pg8::EpiResNorm E{(const pg8::bf16_t*)HA, (pg8::bf16_t*)(P.ws + WS_XB), (float*)(P.ws + WS_RSS), DM};
        pg8::gemm_phase<pg8::EpiResNorm, pg8::StaticOrder, true, true>(lds, g, S, E);
    }
    xcd_barrier(xbar);

    {
        pg8::Gemm g{(const pg8::bf16_t*)(P.ws + WS_XB), (const pg8::bf16_t*)(P.ws + WS_WGU), M, 2 * DFF, DM}; pg8::StaticOrder S; S.init(M, 2 * DFF, G, bx);
        pg8::EpiSwiGLU E{(pg8::bf16_t*)(P.ws + WS_ACT), DFF, (const float*)(P.ws + WS_RSS)};
        for (int rep = 0; rep < REP_G4; ++rep) pg8::gemm_phase<pg8::EpiSwiGLU, pg8::StaticOrder, true, true>(lds, g, S, E);
    }
    xcd_barrier(xbar);

    {
        pg8::Gemm g{(const pg8::bf16_t*)(P.ws + WS_ACT), (const pg8::bf16_t*)(P.ws + WS_WD), M, DM, DFF}; pg8::StaticOrder S; S.init(M, DM, G, bx);
        pg8::EpiRes E{(const pg8::bf16_t*)(P.ws + WS_XB), P.out, DM};
        pg8::gemm_phase<pg8::EpiRes, pg8::StaticOrder, true, true>(lds, g, S, E);
    }
}

extern "C" void kernel_launch(void* const* d_in, const int* in_sizes, int n_in, void* d_out, int out_size, void* d_ws, size_t ws_size, hipStream_t stream) {
    static int grid = 0;
    if (grid == 0) {
        if (n_in != 20 || in_sizes[0] != M * DM || out_size != M * DM || ws_size < WS_END) { fprintf(stderr, "kernel_launch: unexpected shapes (n_in %d, ws %zu)\n", n_in, ws_size); grid = -1; return; }
        int dev = 0, cus = 0, per_cu = 0;
        (void)hipGetDevice(&dev); (void)hipDeviceGetAttribute(&cus, hipDeviceAttributeMultiprocessorCount, dev);
        (void)hipFuncSetAttribute((const void*)hymba_fwd, hipFuncAttributeMaxDynamicSharedMemorySize, LDS_BYTES);
        if (hipOccupancyMaxActiveBlocksPerMultiprocessor(&per_cu, (const void*)hymba_fwd, NTHREADS, LDS_BYTES) != hipSuccess || per_cu < 1) { fprintf(stderr, "kernel_launch: occupancy query failed (%d)\n", per_cu); grid = -1; return; }
        grid = cus * per_cu;
    }
    if (grid < 0) return;
    Params p{};
    const float** pp = (const float**)&p;
    for (int i = 0; i < 20; ++i) pp[i] = (const float*)d_in[i];
    p.out = (float*)d_out; p.ws = (unsigned char*)d_ws;
    void* args[] = {&p};
    hipError_t e = hipLaunchCooperativeKernel((const void*)hymba_fwd, dim3(grid), dim3(NTHREADS), args, LDS_BYTES, stream);
    if (e != hipSuccess) fprintf(stderr, "cooperative launch failed: %s (grid %d)\n", hipGetErrorString(e), grid);
}
```

```cpp
#include <hip/hip_runtime.h>
#include <hip/hip_cooperative_groups.h>
#include <cstdio>
#include <cstdint>
namespace cg = cooperative_groups;
namespace pg8 {
#define PG8_LAS __attribute__((address_space(3)))
typedef unsigned short bf16_t;
typedef short bf16x8 __attribute__((ext_vector_type(8)));
typedef float f32x4 __attribute__((ext_vector_type(4)));
typedef unsigned u32x4 __attribute__((ext_vector_type(4)));
constexpr int BM = 256, BK = 64, HALF = 128, HTB = HALF * BK * 2  , STAGE_BYTES = 8 * HTB, NXCD = 8, WGM = 8;

__host__ __device__ __forceinline__ int lds_byte(int r, int c) { const int st = (r >> 4) * 2 + (c >> 5), rr = r & 15, cc = c & 31, ob = rr * 64 + cc * 2; return st * 1024 + (ob ^ (((ob >> 9) & 1) << 5)); }
__host__ __device__ __forceinline__ void stage_rc(int b, int& R, int& C) { const int st = b / 1024, sb = b % 1024, swz = sb ^ (((sb >> 9) & 1) << 5); R = (st >> 1) * 16 + swz / 64; C = (st & 1) * 32 + (swz % 64) / 2; }
__host__ __device__ __forceinline__ int perm32(int rho) { const int n = rho >> 4, i = rho & 15; return 8 * (i >> 2) + 4 * n + (i & 3); }

struct Unit { int pm, pn; };
struct Gemm { const bf16_t* A; const bf16_t* Bt; int M, N, K; };

struct StaticOrder {
    int nM, nN, nwg, G, c;
    __host__ __device__ void init(int M, int N, int G_, int c_) { nM = M / BM; nN = N / BM; nwg = nM * nN; G = G_; c = c_; }
    __host__ __device__ bool next(int i, Unit& u) const {
        const long L = (long)i * G + c; if (L >= nwg) return false;
        int wgid = (int)L; { const int q = nwg / NXCD, r = nwg % NXCD, xcd = wgid % NXCD, off = wgid / NXCD; wgid = (xcd < r ? xcd * (q + 1) : r * (q + 1) + (xcd - r) * q) + off; }
        const int nig = WGM * nN, gid = wgid / nig, fm = gid * WGM, gsz = (nM - fm) < WGM ? (nM - fm) : WGM;
        u.pm = fm + ((wgid % nig) % gsz); u.pn = (wgid % nig) / gsz; return true;
    }
    __device__ __forceinline__ void a_ready(const Unit&) const {}
    __device__ __forceinline__ void done(const Unit&) const {}
};

__device__ __forceinline__ unsigned cvt_pk_bf16(float lo, float hi) { unsigned r; asm volatile("v_cvt_pk_bf16_f32 %0, %1, %2" : "=v"(r) : "v"(lo), "v"(hi)); return r; }
typedef float f32x2 __attribute__((ext_vector_type(2)));
__device__ __forceinline__ float fast_rcp(float x) { return __builtin_amdgcn_rcpf(x); }
__device__ __forceinline__ float fast_exp(float x) { return __builtin_amdgcn_exp2f(x * 1.4426950408889634f); }
template <bool NT = false> __device__ __forceinline__ void stage_rows128(PG8_LAS unsigned char* stg, int fr, int lane, int cA, u32x4 dA, int cB, u32x4 dB, char* g0, size_t pitch) {
    *(PG8_LAS u32x4*)(stg + fr * 128 + ((cA ^ (fr & 7)) << 4)) = dA;
    *(PG8_LAS u32x4*)(stg + fr * 128 + ((cB ^ (fr & 7)) << 4)) = dB;
    const int r = lane >> 3, c = lane & 7;
    const u32x4 v0 = *(const PG8_LAS u32x4*)(stg + r * 128 + ((c ^ r) << 4));
    const u32x4 v1 = *(const PG8_LAS u32x4*)(stg + (r + 8) * 128 + ((c ^ r) << 4));
    if (NT) { __builtin_nontemporal_store(v0, (u32x4*)(g0 + (size_t)r * pitch + c * 16)); __builtin_nontemporal_store(v1, (u32x4*)(g0 + (size_t)(r + 8) * pitch + c * 16)); }
    else { *(u32x4*)(g0 + (size_t)r * pitch + c * 16) = v0; *(u32x4*)(g0 + (size_t)(r + 8) * pitch + c * 16) = v1; }
}
__device__ __forceinline__ void unstage_issue(const char* g0, size_t pitch, int lane, u32x4& v0, u32x4& v1) {
    const int r = lane >> 3, c = lane & 7;
    v0 = __builtin_nontemporal_load((const u32x4*)(g0 + (size_t)r * pitch + c * 16)); v1 = __builtin_nontemporal_load((const u32x4*)(g0 + (size_t)(r + 8) * pitch + c * 16));
}
__device__ __forceinline__ void unstage_take(PG8_LAS unsigned char* stg, int fr, int lane, const u32x4& v0, const u32x4& v1, int cA, u32x4& dA, int cB, u32x4& dB) {
    const int r = lane >> 3, c = lane & 7;
    *(PG8_LAS u32x4*)(stg + r * 128 + ((c ^ r) << 4)) = v0;
    *(PG8_LAS u32x4*)(stg + (r + 8) * 128 + ((c ^ r) << 4)) = v1;
    dA = *(const PG8_LAS u32x4*)(stg + fr * 128 + ((cA ^ (fr & 7)) << 4));
    dB = *(const PG8_LAS u32x4*)(stg + fr * 128 + ((cB ^ (fr & 7)) << 4));
}
__device__ __forceinline__ void stage_rows64(PG8_LAS unsigned char* stg, int fr, int fq, int lane, u32x4 dA, u32x4 dB, char* g0, char* g1, size_t pitch) {
    *(PG8_LAS u32x4*)(stg + fr * 64 + ((fq ^ ((fr >> 1) & 3)) << 4)) = dA;
    *(PG8_LAS u32x4*)(stg + (16 + fr) * 64 + ((fq ^ ((fr >> 1) & 3)) << 4)) = dB;
    const int r = lane >> 2, c = lane & 3;
    const u32x4 v0 = *(const PG8_LAS u32x4*)(stg + r * 64 + ((c ^ ((r >> 1) & 3)) << 4));
    const u32x4 v1 = *(const PG8_LAS u32x4*)(stg + (16 + r) * 64 + ((c ^ ((r >> 1) & 3)) << 4));
    __builtin_nontemporal_store(v0, (u32x4*)(g0 + (size_t)r * pitch + c * 16));
    __builtin_nontemporal_store(v1, (u32x4*)(g1 + (size_t)r * pitch + c * 16));
}
struct EpiProj {
    static constexpr bool PERM = true, AFTER_DRAIN = false;
    bf16_t* base; size_t stride; const float* gq; const float* gk; float qscale;
    __device__ __forceinline__ void operator()(const f32x4 (&acc)[2][2][4][2], const Unit& u, int wr, int wc, int fr, int fq, PG8_LAS unsigned char* stg, int lane) const {
        const int kind = u.pn >> 1;
        bf16_t* dst = base + (size_t)kind * stride;
        const int rowg = u.pm * BM + wr * 64;
        const int colw = (u.pn & 1) * 256 + 64 * wc;
        if (kind < 2) {
            const float* g = (kind == 0) ? gq : gk; const float sc = (kind == 0) ? qscale : 1.f;
            f32x4 gv[2][2];
#pragma unroll
            for (int bj = 0; bj < 2; ++bj)
#pragma unroll
                for (int n = 0; n < 2; ++n) gv[bj][n] = *(const f32x4*)(g + 32 * bj + 8 * fq + 4 * n) * sc;
#pragma unroll
            for (int ai = 0; ai < 2; ++ai)
#pragma unroll
                for (int m = 0; m < 4; ++m) {
                    float ss = 0.f;
#pragma unroll
                    for (int bj = 0; bj < 2; ++bj)
#pragma unroll
                        for (int n = 0; n < 2; ++n) { const f32x4 x = acc[ai][bj][m][n]; ss += (x[0] * x[0] + x[1] * x[1]) + (x[2] * x[2] + x[3] * x[3]); }
                    ss += __shfl_xor(ss, 16); ss += __shfl_xor(ss, 32);
                    const float rs = rsqrtf(ss * (1.0f / 64.0f) + 1e-6f);
                    u32x4 w[2];
#pragma unroll
                    for (int bj = 0; bj < 2; ++bj) { const f32x4 v0 = acc[ai][bj][m][0] * rs * gv[bj][0], v1 = acc[ai][bj][m][1] * rs * gv[bj][1];
                        w[bj].x = cvt_pk_bf16(v0[0], v0[1]); w[bj].y = cvt_pk_bf16(v0[2], v0[3]); w[bj].z = cvt_pk_bf16(v1[0], v1[1]); w[bj].w = cvt_pk_bf16(v1[2], v1[3]); }
                    stage_rows128<true>(stg, fr, lane, fq, w[0], 4 + fq, w[1], (char*)(dst + (size_t)(rowg + ai * HALF + m * 16) * 512 + colw), 1024);
                }
        } else {
#pragma unroll
            for (int ai = 0; ai < 2; ++ai)
#pragma unroll
                for (int m = 0; m < 4; ++m) { u32x4 w[2];
#pragma unroll
                    for (int bj = 0; bj < 2; ++bj) { const f32x4 v0 = acc[ai][bj][m][0], v1 = acc[ai][bj][m][1];
                        w[bj].x = cvt_pk_bf16(v0[0], v0[1]); w[bj].y = cvt_pk_bf16(v0[2], v0[3]); w[bj].z = cvt_pk_bf16(v1[0], v1[1]); w[bj].w = cvt_pk_bf16(v1[2], v1[3]); }
                    stage_rows128<true>(stg, fr, lane, fq, w[0], 4 + fq, w[1], (char*)(dst + (size_t)(rowg + ai * HALF + m * 16) * 512 + colw), 1024); }
        }
    }
};
struct EpiSwiGLU {
    static constexpr bool PERM = true, AFTER_DRAIN = false;
    bf16_t* O; int ldc; const float* rss;
    __device__ __forceinline__ void operator()(const f32x4 (&acc)[2][2][4][2], const Unit& u, int wr, int wc, int fr, int fq, PG8_LAS unsigned char* stg, int lane) const {
        const int row0 = u.pm * BM + wr * 64 + fr, col0 = u.pn * 128 + wc * 32 + 8 * fq;
        float rsv[2][4];
#pragma unroll
        for (int ai = 0; ai < 2; ++ai)
#pragma unroll
            for (int m = 0; m < 4; ++m) rsv[ai][m] = rsqrtf(rss[row0 + ai * HALF + m * 16] * (1.0f / 1024.0f) + 1e-6f);
#pragma unroll
        for (int ai = 0; ai < 2; ++ai)
#pragma unroll
            for (int mp = 0; mp < 2; ++mp) { u32x4 w[2];
#pragma unroll
                for (int mm = 0; mm < 2; ++mm) { const int m = 2 * mp + mm; f32x4 a[2];
                    const float rs = rsv[ai][m], ce = -1.4426950408889634f * rs, rs2 = rs * rs;
#pragma unroll
                    for (int n = 0; n < 2; ++n) { const f32x4 g = acc[ai][0][m][n], gu = g * acc[ai][1][m][n]; f32x4 e = g * ce;
#pragma unroll
                        for (int i = 0; i < 4; ++i) e[i] = __builtin_amdgcn_exp2f(e[i]);
                        e = e + 1.0f;
#pragma unroll
                        for (int i = 0; i < 4; ++i) e[i] = __builtin_amdgcn_rcpf(e[i]);
                        a[n] = gu * (e * rs2); }
                    w[mm].x = cvt_pk_bf16(a[0][0], a[0][1]); w[mm].y = cvt_pk_bf16(a[0][2], a[0][3]); w[mm].z = cvt_pk_bf16(a[1][0], a[1][1]); w[mm].w = cvt_pk_bf16(a[1][2], a[1][3]); }
                char* g0 = (char*)(O + (size_t)(u.pm * BM + wr * 64 + ai * HALF + 32 * mp) * ldc + u.pn * 128 + wc * 32);
                stage_rows64(stg, fr, fq, lane, w[0], w[1], g0, g0 + (size_t)16 * ldc * 2, (size_t)ldc * 2); }
    }
};
struct EpiResNorm {
    static constexpr bool PERM = true, AFTER_DRAIN = false;
    const float* base; bf16_t* xb; float* rss; int ldc;
    __device__ __forceinline__ void operator()(const f32x4 (&acc)[2][2][4][2], const Unit& u, int wr, int wc, int fr, int fq, PG8_LAS unsigned char* stg, int lane) const {
        const int rowg = u.pm * BM + wr * 64, colw = u.pn * BM + 64 * wc;
#pragma unroll
        for (int ai = 0; ai < 2; ++ai)
#pragma unroll
            for (int mp = 0; mp < 2; ++mp) {
                u32x4 ld[2][2][2];
#pragma unroll
                for (int mm = 0; mm < 2; ++mm)
#pragma unroll
                    for (int bj = 0; bj < 2; ++bj) unstage_issue((const char*)(base + (size_t)(rowg + ai * HALF + (2 * mp + mm) * 16) * ldc + colw + 32 * bj), (size_t)ldc * 4, lane, ld[mm][bj][0], ld[mm][bj][1]);
#pragma unroll
                for (int mm = 0; mm < 2; ++mm) { const int m = 2 * mp + mm; const int row = rowg + ai * HALF + m * 16 + fr; float ss = 0.f; u32x4 w[2];
#pragma unroll
                    for (int bj = 0; bj < 2; ++bj) { u32x4 xa, xb2; unstage_take(stg, fr, lane, ld[mm][bj][0], ld[mm][bj][1], 2 * fq, xa, 2 * fq + 1, xb2);
                        f32x4 v[2]; v[0] = __builtin_bit_cast(f32x4, xa) + acc[ai][bj][m][0]; v[1] = __builtin_bit_cast(f32x4, xb2) + acc[ai][bj][m][1];
#pragma unroll
                        for (int n = 0; n < 2; ++n) ss += (v[n][0] * v[n][0] + v[n][1] * v[n][1]) + (v[n][2] * v[n][2] + v[n][3] * v[n][3]);
                        w[bj].x = cvt_pk_bf16(v[0][0], v[0][1]); w[bj].y = cvt_pk_bf16(v[0][2], v[0][3]); w[bj].z = cvt_pk_bf16(v[1][0], v[1][1]); w[bj].w = cvt_pk_bf16(v[1][2], v[1][3]); }
                    stage_rows128(stg, fr, lane, fq, w[0], 4 + fq, w[1], (char*)(xb + (size_t)(rowg + ai * HALF + m * 16) * ldc + colw), (size_t)ldc * 2);
                    ss += __shfl_xor(ss, 16); ss += __shfl_xor(ss, 32);
                    if (fq == 0) atomicAdd(rss + row, ss); }
                asm volatile("" ::: "memory"); }
    }
};
struct EpiRes {
    static constexpr bool PERM = true, AFTER_DRAIN = false;
    const bf16_t* base; float* out; int ldc;
    __device__ __forceinline__ void operator()(const f32x4 (&acc)[2][2][4][2], const Unit& u, int wr, int wc, int fr, int fq, PG8_LAS unsigned char* stg, int lane) const {
        u32x4 l0[2][4], l1[2][4];
        { const int r = lane >> 3, c = lane & 7; const bf16_t* gp = base + (size_t)(u.pm * BM + wr * 64) * ldc + u.pn * BM + wc * 32 + (c >> 2) * HALF + (c & 3) * 8;
#pragma unroll
          for (int ai = 0; ai < 2; ++ai)
#pragma unroll
              for (int m = 0; m < 4; ++m) { l0[ai][m] = __builtin_nontemporal_load((const u32x4*)(gp + (size_t)(ai * HALF + m * 16 + r) * ldc)); l1[ai][m] = __builtin_nontemporal_load((const u32x4*)(gp + (size_t)(ai * HALF + m * 16 + r + 8) * ldc)); } }
#pragma unroll
        for (int ai = 0; ai < 2; ++ai)
#pragma unroll
            for (int m = 0; m < 4; ++m) {
                u32x4 rb[2]; unstage_take(stg, fr, lane, l0[ai][m], l1[ai][m], fq, rb[0], 4 + fq, rb[1]);
#pragma unroll
                for (int bj = 0; bj < 2; ++bj) { const u32x4 b = rb[bj];
                    const f32x4 b0 = {__uint_as_float(b.x << 16), __uint_as_float(b.x & 0xffff0000u), __uint_as_float(b.y << 16), __uint_as_float(b.y & 0xffff0000u)};
                    const f32x4 b1 = {__uint_as_float(b.z << 16), __uint_as_float(b.z & 0xffff0000u), __uint_as_float(b.w << 16), __uint_as_float(b.w & 0xffff0000u)};
                    const f32x4 o0 = b0 + acc[ai][bj][m][0], o1 = b1 + acc[ai][bj][m][1];
                    stage_rows128<true>(stg, fr, lane, 2 * fq, __builtin_bit_cast(u32x4, o0), 2 * fq + 1, __builtin_bit_cast(u32x4, o1),
                                  (char*)(out + (size_t)(u.pm * BM + wr * 64 + ai * HALF + m * 16) * ldc + u.pn * BM + bj * HALF + wc * 32), (size_t)ldc * 4); } }
    }
};
template <class Epi, class Sched, bool ALIGN_EPI = false, bool SP2 = false>
__device__ __forceinline__ void gemm_phase(PG8_LAS unsigned char* lds, const Gemm g, const Sched& S, const Epi& E) {
    int tid_ = threadIdx.x; asm volatile("" : "+v"(tid_));
    const int tid = tid_, wid = __builtin_amdgcn_readfirstlane(tid >> 6), lane = tid & 63, wr = wid >> 2, wc = wid & 3, fr = lane & 15, fq = lane >> 4;
    const int K = g.K, nt = K / BK;
    unsigned voffA[2], voffB[2];
#pragma unroll
    for (int i = 0; i < 2; ++i) { int R, C; stage_rc(tid * 16 + i * 8192, R, C); const int Rb = Epi::PERM ? ((R & ~31) + perm32(R & 31)) : R;
        voffA[i] = (unsigned)(R * K + C) * 2u; voffB[i] = (unsigned)(Rb * K + C) * 2u; }
    const size_t kstep = (size_t)(BK * 2);
    const size_t hstep = (size_t)HALF * K * 2;
    const size_t tstep = 2 * hstep;
    const unsigned ldsw = (unsigned)wid * 1024u;
    const int aoff = lds_byte(wr * 64 + fr, fq * 8), boff = lds_byte(wc * 32 + fr, fq * 8);
#define PG8_SA(b, h) (((b) * 2 + (h)) * HTB)
#define PG8_SB(b, h) ((4 + (b) * 2 + (h)) * HTB)
#define PG8_STAGE(bufoff, gbase, voff) do { _Pragma("unroll") for (int _i = 0; _i < 2; ++_i) \
        __builtin_amdgcn_global_load_lds((const unsigned*)((const char*)(gbase) + (voff)[_i]), (PG8_LAS unsigned*)(lds + (bufoff) + ldsw + _i * 8192), 16, 0, 0); } while (0)
#define PG8_LDA(dst, b, h) do { _Pragma("unroll") for (int m = 0; m < 4; ++m) _Pragma("unroll") for (int k = 0; k < 2; ++k) dst[m][k] = *(const PG8_LAS bf16x8*)(lds + PG8_SA(b, h) + aoff + m * 2048 + k * 1024); } while (0)
#define PG8_LDB(dst, b, h) do { _Pragma("unroll") for (int n = 0; n < 2; ++n) _Pragma("unroll") for (int k = 0; k < 2; ++k) dst[n][k] = *(const PG8_LAS bf16x8*)(lds + PG8_SB(b, h) + boff + n * 2048 + k * 1024); } while (0)
#define PG8_MMA(ai, bj, At, Bt) do { __builtin_amdgcn_s_setprio(1); _Pragma("unroll") for (int m = 0; m < 4; ++m) _Pragma("unroll") for (int n = 0; n < 2; ++n) _Pragma("unroll") for (int k = 0; k < 2; ++k) \
        acc[ai][bj][m][n] = __builtin_amdgcn_mfma_f32_16x16x32_bf16(Bt[n][k], At[m][k], acc[ai][bj][m][n], 0, 0, 0); __builtin_amdgcn_s_setprio(0); } while (0)
#define PG8_WAIT_V(n) asm volatile("s_waitcnt vmcnt(" #n ")" ::: "memory")
#define PG8_WAIT_L(n) asm volatile("s_waitcnt lgkmcnt(" #n ")" ::: "memory")
#define PG8_BAR __builtin_amdgcn_s_barrier()
#define PG8_SCHED __builtin_amdgcn_sched_barrier(0)
    Unit cur, nxt; int ui = 0;
    if (!S.next(0, cur)) return;
    f32x4 acc[2][2][4][2];
#pragma unroll
    for (int a = 0; a < 2; ++a)
#pragma unroll
        for (int b = 0; b < 2; ++b)
#pragma unroll
            for (int m = 0; m < 4; ++m)
#pragma unroll
                for (int n = 0; n < 2; ++n) acc[a][b][m][n] = (f32x4){0.f, 0.f, 0.f, 0.f};
    bf16x8 At[4][2], B0[2][2], B1[2][2];
    const char* cA = (const char*)g.A + (size_t)cur.pm * tstep; const char* cB = (const char*)g.Bt + (size_t)cur.pn * tstep;
    S.a_ready(cur);
    if constexpr (SP2) {
        PG8_STAGE(PG8_SB(0, 0), cB, voffB); PG8_STAGE(PG8_SB(0, 1), cB + hstep, voffB); PG8_STAGE(PG8_SA(0, 0), cA, voffA); PG8_STAGE(PG8_SA(0, 1), cA + hstep, voffA);
        if (wr == 1) PG8_BAR;
        PG8_WAIT_V(2); PG8_BAR;
        PG8_STAGE(PG8_SB(1, 0), cB + kstep, voffB); PG8_STAGE(PG8_SA(1, 0), cA + kstep, voffA); PG8_STAGE(PG8_SB(1, 1), cB + hstep + kstep, voffB);
        PG8_WAIT_V(6); PG8_BAR;
    } else {
        PG8_STAGE(PG8_SB(0, 0), cB, voffB); PG8_STAGE(PG8_SA(0, 0), cA, voffA); PG8_STAGE(PG8_SB(0, 1), cB + hstep, voffB); PG8_STAGE(PG8_SA(0, 1), cA + hstep, voffA);
        if (wr == 1) PG8_BAR;
        PG8_WAIT_V(4); PG8_BAR;
        PG8_STAGE(PG8_SB(1, 0), cB + kstep, voffB); PG8_STAGE(PG8_SA(1, 0), cA + kstep, voffA); PG8_STAGE(PG8_SB(1, 1), cB + hstep + kstep, voffB);
        PG8_WAIT_V(6); PG8_BAR;
    }
    for (;;) {
        const bool has_next = S.next(ui + 1, nxt);
        const char* nA = has_next ? (const char*)g.A + (size_t)nxt.pm * tstep : cA; const char* nB = has_next ? (const char*)g.Bt + (size_t)nxt.pn * tstep : cB;
        for (int t = 0; t < nt; t += 2) {
            const bool last = (t == nt - 2);
            const char* a1 = cA + (size_t)(t + 1) * kstep;
            const char* a2 = last ? nA : cA + (size_t)(t + 2) * kstep; const char* b2 = last ? nB : cB + (size_t)(t + 2) * kstep;
            const char* a3 = a2 + kstep; const char* b3 = b2 + kstep;
            if (last && has_next) S.a_ready(nxt);
            if constexpr (SP2) {
            PG8_LDB(B0, 0, 0); PG8_LDB(B1, 0, 1); PG8_SCHED; PG8_LDA(At, 0, 0); PG8_STAGE(PG8_SA(1, 1), a1 + hstep, voffA);
            PG8_WAIT_V(8); PG8_WAIT_L(0); PG8_BAR; PG8_MMA(0, 0, At, B0); PG8_MMA(0, 1, At, B1); PG8_BAR; PG8_SCHED;
            PG8_LDA(At, 0, 1); PG8_STAGE(PG8_SB(0, 0), b2, voffB); PG8_STAGE(PG8_SB(0, 1), b2 + hstep, voffB); PG8_STAGE(PG8_SA(0, 0), a2, voffA);
            PG8_WAIT_V(8); PG8_WAIT_L(0); PG8_BAR; PG8_MMA(1, 0, At, B0); PG8_MMA(1, 1, At, B1); PG8_BAR; PG8_SCHED;
            PG8_LDB(B0, 1, 0); PG8_LDB(B1, 1, 1); PG8_SCHED; PG8_LDA(At, 1, 0); PG8_STAGE(PG8_SA(0, 1), a2 + hstep, voffA);
            PG8_WAIT_V(8); PG8_WAIT_L(0); PG8_BAR; PG8_MMA(0, 0, At, B0); PG8_MMA(0, 1, At, B1); PG8_BAR; PG8_SCHED;
            PG8_LDA(At, 1, 1); PG8_STAGE(PG8_SB(1, 0), b3, voffB); PG8_STAGE(PG8_SB(1, 1), b3 + hstep, voffB); PG8_STAGE(PG8_SA(1, 0), a3, voffA);
            PG8_WAIT_V(8); PG8_WAIT_L(0); PG8_BAR; PG8_MMA(1, 0, At, B0); PG8_MMA(1, 1, At, B1); PG8_BAR; PG8_SCHED;
            } else {
            PG8_LDB(B0, 0, 0); PG8_SCHED; PG8_LDA(At, 0, 0); PG8_STAGE(PG8_SA(1, 1), a1 + hstep, voffA);
            PG8_WAIT_L(8); PG8_BAR; PG8_WAIT_L(0); PG8_MMA(0, 0, At, B0); PG8_BAR; PG8_SCHED;
            PG8_LDB(B1, 0, 1); PG8_STAGE(PG8_SB(0, 0), b2, voffB);
            PG8_BAR; PG8_WAIT_L(0); PG8_MMA(0, 1, At, B1); PG8_BAR;
            PG8_LDA(At, 0, 1); PG8_STAGE(PG8_SA(0, 0), a2, voffA);
            PG8_BAR; PG8_WAIT_L(0); PG8_MMA(1, 0, At, B0); PG8_BAR; PG8_SCHED;
            PG8_STAGE(PG8_SB(0, 1), b2 + hstep, voffB);
            PG8_WAIT_V(6); PG8_BAR; PG8_MMA(1, 1, At, B1); PG8_BAR;
            PG8_LDB(B0, 1, 0); PG8_SCHED; PG8_LDA(At, 1, 0); PG8_STAGE(PG8_SA(0, 1), a2 + hstep, voffA);
            PG8_WAIT_L(8); PG8_BAR; PG8_WAIT_L(0); PG8_MMA(0, 0, At, B0); PG8_BAR; PG8_SCHED;
            PG8_LDB(B1, 1, 1); PG8_STAGE(PG8_SB(1, 0), b3, voffB);
            PG8_BAR; PG8_WAIT_L(0); PG8_MMA(0, 1, At, B1); PG8_BAR;
            PG8_LDA(At, 1, 1); PG8_STAGE(PG8_SA(1, 0), a3, voffA);
            PG8_BAR; PG8_WAIT_L(0); PG8_MMA(1, 0, At, B0); PG8_BAR; PG8_SCHED;
            PG8_STAGE(PG8_SB(1, 1), b3 + hstep, voffB);
            PG8_WAIT_V(6); PG8_BAR; PG8_MMA(1, 1, At, B1); PG8_BAR;
            }
        }
        if constexpr (ALIGN_EPI) { if (wr == 0) PG8_BAR; }
        if constexpr (!Epi::AFTER_DRAIN) { E(acc, cur, wr, wc, fr, fq, lds + STAGE_BYTES + wid * 2048, lane); S.done(cur); }
        if (!has_next) break;
#pragma unroll
        for (int a = 0; a < 2; ++a)
#pragma unroll
            for (int b = 0; b < 2; ++b)
#pragma unroll
                for (int m = 0; m < 4; ++m)
#pragma unroll
                    for (int n = 0; n < 2; ++n) acc[a][b][m][n] = (f32x4){0.f, 0.f, 0.f, 0.f};
        cur = nxt; cA = nA; cB = nB; ++ui;
        if constexpr (ALIGN_EPI) { if (wr == 1) PG8_BAR; }
    }
    PG8_WAIT_V(0);
    if constexpr (!ALIGN_EPI) { if (wr == 0) PG8_BAR; }
    PG8_BAR;
    if constexpr (Epi::AFTER_DRAIN) { E.fused(acc, cur, wr, wc, fr, fq, lds, wid, lane); S.done(cur); }
#undef PG8_SA
#undef PG8_SB
#undef PG8_STAGE
#undef PG8_LDA
#undef PG8_LDB
#undef PG8_MMA
#undef PG8_WAIT_V
#undef PG8_WAIT_L
#undef PG8_BAR
#undef PG8_SCHED
}
}
constexpr int BATCH = 16, SEQ = 4096, DM = 1024, NH = 8, HD = 64, AW = 512, LW = 512, DFF = 2816, INW = 2568;
constexpr int M = BATCH * SEQ;
constexpr int NPROJ = 2560;
constexpr float NORM_EPS = 1e-6f, LOG2E = 1.4426950408889634f;
constexpr float QSCALE = 0.125f * 1.4426950408889634f;
constexpr int NWAVES = 8, NTHREADS = 512;
constexpr int LT = 64, NLT = SEQ / LT;

constexpr size_t MiB = 1u << 20;
constexpr size_t WS_W1 = 0;
constexpr size_t WS_WO = 6 * MiB;
constexpr size_t WS_WGU = 8 * MiB;
constexpr size_t WS_WD = 20 * MiB;
constexpr size_t WS_WG = 26 * MiB;
constexpr size_t WS_LOGF = 27 * MiB;
constexpr size_t WS_F = 29 * MiB;
constexpr size_t WS_AGGA = 31 * MiB, WS_AGGH = 33 * MiB;
constexpr size_t WS_HA = 36 * MiB;
constexpr size_t WS_Q = 164 * MiB;
constexpr size_t SZ_T = 64 * MiB;
constexpr size_t WS_ATT = WS_Q + 5 * SZ_T, WS_HL = WS_Q + 6 * SZ_T, WS_AC = WS_Q + 7 * SZ_T;
constexpr size_t WS_XB = WS_Q;
constexpr size_t WS_ACT = WS_Q + 2 * SZ_T;
constexpr size_t WS_BAR = 35 * MiB + 512 * 1024;
constexpr size_t WS_RSS = 35 * MiB;
constexpr size_t WS_END = WS_Q + 8 * SZ_T;
static_assert(WS_ACT + (size_t)M * DFF * 2 <= WS_END, "act overlay");

#define LAS __attribute__((address_space(3)))
typedef unsigned short bf16;
typedef unsigned u32x4 __attribute__((ext_vector_type(4)));
typedef unsigned u32x2 __attribute__((ext_vector_type(2)));
typedef float f32x4 __attribute__((ext_vector_type(4)));
typedef float f32x16 __attribute__((ext_vector_type(16)));
typedef short bf16x8 __attribute__((ext_vector_type(8)));
typedef short s16x4 __attribute__((ext_vector_type(4)));
typedef float f32x2_t __attribute__((ext_vector_type(2))); typedef __bf16 bf16x2_t __attribute__((ext_vector_type(2)));
__device__ __forceinline__ unsigned pk2(float lo, float hi) { const f32x2_t v = {lo, hi}; return __builtin_bit_cast(unsigned, __builtin_convertvector(v, bf16x2_t)); }
__device__ __forceinline__ float bflo(unsigned w) { return __uint_as_float(w << 16); }
__device__ __forceinline__ float bfhi(unsigned w) { return __uint_as_float(w & 0xffff0000u); }
__device__ __forceinline__ float ex2(float x) { return __builtin_amdgcn_exp2f(x); }
__device__ __forceinline__ float wave_sum(float v) {
#pragma unroll
    for (int o = 1; o < 64; o <<= 1) v += __shfl_xor(v, o);
    return v;
}
__device__ __forceinline__ float sigmoidf_(float z) { return __builtin_amdgcn_rcpf(1.f + ex2(-z * LOG2E)); }

__device__ __forceinline__ void transpose_item(const float* src, int ldw, bf16* dst  , int K, LAS float* scr, int lane, const float* ksc = nullptr  ) {
    if ((ldw & 3) == 0 && (((size_t)src) & 15) == 0) {
        f32x4 v[8];
#pragma unroll
        for (int i = 0; i < 8; ++i) v[i] = *(const f32x4*)(src + (size_t)(8 * i + (lane >> 3)) * ldw + 4 * (lane & 7));
#pragma unroll
        for (int i = 0; i < 8; ++i) { const int kk = 8 * i + (lane >> 3); const float sc = ksc ? ksc[kk] : 1.f;
#pragma unroll
            for (int q = 0; q < 4; ++q) scr[kk * 33 + 4 * (lane & 7) + q] = v[i][q] * sc; }
    } else {
#pragma unroll 8
        for (int i = 0; i < 32; ++i) { const int kk = 2 * i + (lane >> 5); float v = src[(size_t)kk * ldw + (lane & 31)]; if (ksc) v *= ksc[kk]; scr[kk * 33 + (lane & 31)] = v; }
    }
    asm volatile("s_waitcnt lgkmcnt(0)" ::: "memory");
    const int c = lane & 7;
#pragma unroll
    for (int j = 0; j < 4; ++j) { const int n = (lane >> 3) + 8 * j; const LAS float* s = scr + (8 * c) * 33 + n;
        u32x4 o; o.x = pk2(s[0 * 33], s[1 * 33]); o.y = pk2(s[2 * 33], s[3 * 33]); o.z = pk2(s[4 * 33], s[5 * 33]); o.w = pk2(s[6 * 33], s[7 * 33]);
        *(u32x4*)(dst + (size_t)n * K + 8 * c) = o; }
    asm volatile("s_waitcnt lgkmcnt(0)" ::: "memory");
}

struct Params {
    const float* x; const float* norm1_g; const float* w_in; const float* q_g; const float* k_g; const float* b_f; const float* conv_w; const float* conv_b;
    const float* w_a; const float* b_a; const float* w_x; const float* b_x; const float* lam; const float* att_g; const float* lru_g; const float* w_out;
    const float* norm2_g; const float* w_gate; const float* w_up; const float* w_down;
    float* out; unsigned char* ws;
};

__device__ __forceinline__ void p0_weights(const Params& P, LAS unsigned char* lds, int gw, int ngw, int wave, int lane) {
    LAS float* scr = (LAS float*)(lds + wave * 8704);
    bf16* W1 = (bf16*)(P.ws + WS_W1); bf16* WO = (bf16*)(P.ws + WS_WO); bf16* WGU = (bf16*)(P.ws + WS_WGU); bf16* WD = (bf16*)(P.ws + WS_WD); bf16* WG = (bf16*)(P.ws + WS_WG);
    constexpr int I1 = 16 * (NPROJ / 32), I2 = 16 * (DM / 32), I3 = 16 * (2 * DFF / 32), I4 = (DFF / 64) * (DM / 32), I5 = 32;
    for (int it = gw; it < I1 + I2 + I3 + I4 + I5; it += ngw) {
        int r = it;
        if (r < I1) { const int nb = r % (NPROJ / 32), kb = r / (NPROJ / 32), n0 = nb * 32;
            const int pn = n0 >> 8, p = n0 & 255, bj = p >> 7, wc = (p >> 5) & 3; const int L = 256 * pn + 64 * wc + 32 * bj; const int sc = (L < 1536) ? L : L + 8;
            transpose_item(P.w_in + (size_t)(64 * kb) * INW + sc, INW, W1 + (size_t)n0 * DM + 64 * kb, DM, scr, lane); continue; }
        r -= I1;
        if (r < I2) { const int nb = r % (DM / 32), kb = r / (DM / 32), n0 = nb * 32;
            const int pn = n0 >> 8, p = n0 & 255, bj = p >> 7, wc = (p >> 5) & 3; const int L = 256 * pn + 64 * wc + 32 * bj;
            transpose_item(P.w_out + (size_t)(64 * kb) * DM + L, DM, WO + (size_t)n0 * DM + 64 * kb, DM, scr, lane); continue; }
        r -= I2;
        if (r < I3) { const int nb = r % (2 * DFF / 32), kb = r / (2 * DFF / 32), n0 = nb * 32; const int pn = n0 >> 8, p = n0 & 255;
            const float* src = (p < 128) ? (P.w_gate + 128 * pn + p) : (P.w_up + 128 * pn + p - 128);
            transpose_item(src + (size_t)(64 * kb) * DFF, DFF, WGU + (size_t)n0 * DM + 64 * kb, DM, scr, lane, P.norm2_g + 64 * kb); continue; }
        r -= I3;
        if (r < I4) { const int nb = r % (DM / 32), kb = r / (DM / 32);
            transpose_item(P.w_down + (size_t)(64 * kb) * DM + 32 * nb, DM, WD + (size_t)(32 * nb) * DFF + 64 * kb, DFF, scr, lane); continue; }
        r -= I4;
        { const int gn = r >> 1, nb = r & 1; const float* src = ((gn < 8) ? P.w_a : P.w_x) + (size_t)(gn & 7) * 4096 + 32 * nb;
            transpose_item(src, 64, WG + (size_t)gn * 4096 + (size_t)(32 * nb) * 64, 64, scr, lane); }
    }
}

template <bool LOGF>
__device__ __forceinline__ void row_pass(const float* src, const float* g, bf16* dst, const float* w_in, const float* b_f, float* logf, int gw, int ngw, int lane) {
    f32x4 gv[4];
#pragma unroll
    for (int j = 0; j < 4; ++j) gv[j] = *(const f32x4*)(g + 4 * lane + 256 * j);
    f32x4 wf[4][4][2];
    if (LOGF) {
#pragma unroll
        for (int j = 0; j < 4; ++j)
#pragma unroll
            for (int i = 0; i < 4; ++i) { const float* wp = w_in + (size_t)(256 * j + 4 * lane + i) * INW + 1536; wf[j][i][0] = *(const f32x4*)wp; wf[j][i][1] = *(const f32x4*)(wp + 4); }
    }
    f32x4 nv[4];
    if (gw < M) {
#pragma unroll
        for (int j = 0; j < 4; ++j) nv[j] = __builtin_nontemporal_load((const f32x4*)(src + (size_t)gw * DM) + lane + 64 * j);
    }
    for (int m = gw; m < M; m += ngw) {
        f32x4 v[4]; float s = 0.f;
#pragma unroll
        for (int j = 0; j < 4; ++j) v[j] = nv[j];
        if (m + ngw < M) {
#pragma unroll
            for (int j = 0; j < 4; ++j) nv[j] = __builtin_nontemporal_load((const f32x4*)(src + (size_t)(m + ngw) * DM) + lane + 64 * j);
        }
#pragma unroll
        for (int j = 0; j < 4; ++j) s += (v[j][0] * v[j][0] + v[j][1] * v[j][1]) + (v[j][2] * v[j][2] + v[j][3] * v[j][3]);
        const float rs = rsqrtf(wave_sum(s) * (1.f / DM) + NORM_EPS);
#pragma unroll
        for (int j = 0; j < 4; ++j) v[j] = v[j] * rs * gv[j];
        unsigned long long* o8 = (unsigned long long*)(dst + (size_t)m * DM) + lane;
#pragma unroll
        for (int j = 0; j < 4; ++j) o8[64 * j] = (unsigned long long)pk2(v[j][0], v[j][1]) | ((unsigned long long)pk2(v[j][2], v[j][3]) << 32);
        if (LOGF) {
            f32x4 a0 = {0.f, 0.f, 0.f, 0.f}, a1 = {0.f, 0.f, 0.f, 0.f};
#pragma unroll
            for (int j = 0; j < 4; ++j)
#pragma unroll
                for (int i = 0; i < 4; ++i) { a0 += wf[j][i][0] * v[j][i]; a1 += wf[j][i][1] * v[j][i]; }
            float z[8];
#pragma unroll
            for (int hh = 0; hh < 4; ++hh) { z[hh] = wave_sum(a0[hh]); z[4 + hh] = wave_sum(a1[hh]); }
            float zz = z[0];
#pragma unroll
            for (int hh = 1; hh < 8; ++hh) zz = (lane == hh) ? z[hh] : zz;
            if (lane < 8) { zz += b_f[lane]; const float lf = fminf(zz, 0.f) - log1pf(expf(-fabsf(zz)));
                const int b = m / SEQ, s_ = m % SEQ; logf[((size_t)(b * NH + lane)) * SEQ + s_] = lf; }
        }
    }
}

__device__ __forceinline__ void cumsum_seq(const float* logf, float* F, int seq, int lane) {
    const f32x4* src = (const f32x4*)(logf + (size_t)seq * SEQ + 64 * lane);
    f32x4 v[16]; float s = 0.f;
#pragma unroll
    for (int i = 0; i < 16; ++i) { v[i] = src[i]; s += (v[i][0] + v[i][1]) + (v[i][2] + v[i][3]); }
    float inc = s;
#pragma unroll
    for (int o = 1; o < 64; o <<= 1) { const float t = __shfl_up(inc, o); if (lane >= o) inc += t; }
    float run = inc - s;
    f32x4* dst = (f32x4*)(F + (size_t)seq * SEQ + 64 * lane);
#pragma unroll
    for (int i = 0; i < 16; ++i) { f32x4 o; run += v[i][0]; o[0] = run; run += v[i][1]; o[1] = run; run += v[i][2]; o[2] = run; run += v[i][3]; o[3] = run; dst[i] = o; }
}

__device__ __forceinline__ void lru_unit(const Params& P, int b, int c, LAS unsigned char* lds, int wave, int lane) {
    const int fr = lane & 15, fq = lane >> 4;
    const bf16* LX = (const bf16*)(P.ws + WS_Q + 3 * SZ_T);
    const bf16* WG = (const bf16*)(P.ws + WS_WG);
    unsigned* HLAC = (unsigned*)(P.ws + WS_HL);
    LAS unsigned char* stg = lds + wave * (64 * 272);
    float* AGGA = (float*)(P.ws + WS_AGGA); float* AGGH = (float*)(P.ws + WS_AGGH);
    const size_t rowbase = (size_t)b * SEQ; const int tb = c * LT;
    float ba[4], bx[4], c8[4];
#pragma unroll
    for (int nn = 0; nn < 4; ++nn) { const int e = 64 * wave + 16 * nn + fr; ba[nn] = P.b_a[e]; bx[nn] = P.b_x[e]; c8[nn] = P.lam[e]; }
    bf16x8 wan[2], wxn[2];
#pragma unroll
    for (int kk = 0; kk < 2; ++kk) { wan[kk] = *(const bf16x8*)(WG + ((size_t)(wave) * 64 + fr) * 64 + 32 * kk + 8 * fq); wxn[kk] = *(const bf16x8*)(WG + ((size_t)(8 + wave) * 64 + fr) * 64 + 32 * kk + 8 * fq); }
    {
        u32x4 lr[9];
#pragma unroll
        for (int i = 0; i < 9; ++i) { const int row = 8 * i + (lane >> 3); const int tt = tb + row - 3; lr[i] = (u32x4){0u, 0u, 0u, 0u};
            if (row < 67 && tt >= 0) lr[i] = __builtin_nontemporal_load((const u32x4*)(LX + (rowbase + tt) * LW + 64 * wave + 8 * (lane & 7))); }
#pragma unroll
        for (int i = 0; i < 9; ++i) { const int row = 8 * i + (lane >> 3); *(LAS u32x4*)(stg + row * 144 + (lane & 7) * 16) = lr[i]; }
    }
    bf16x8 xa[4][2];
#pragma unroll
    for (int kk = 0; kk < 2; ++kk) {
        const int ch0 = 64 * wave + 32 * kk + 8 * fq;
        f32x4 cw[4][2], cb[2];
#pragma unroll
        for (int j = 0; j < 4; ++j) { cw[j][0] = *(const f32x4*)(P.conv_w + j * LW + ch0); cw[j][1] = *(const f32x4*)(P.conv_w + j * LW + ch0 + 4); }
        cb[0] = *(const f32x4*)(P.conv_b + ch0); cb[1] = *(const f32x4*)(P.conv_b + ch0 + 4);
#pragma unroll
        for (int m = 0; m < 4; ++m) {
            const int tl = 16 * (fr >> 2) + 4 * m + (fr & 3);
            u32x4 w[4];
#pragma unroll
            for (int j = 0; j < 4; ++j) w[j] = *(const LAS u32x4*)(stg + (tl + j) * 144 + (32 * kk + 8 * fq) * 2);
            f32x4 a0 = cb[0], a1 = cb[1];
#pragma unroll
            for (int j = 0; j < 4; ++j) {
                a0[0] += bflo(w[j].x) * cw[j][0][0]; a0[1] += bfhi(w[j].x) * cw[j][0][1]; a0[2] += bflo(w[j].y) * cw[j][0][2]; a0[3] += bfhi(w[j].y) * cw[j][0][3];
                a1[0] += bflo(w[j].z) * cw[j][1][0]; a1[1] += bfhi(w[j].z) * cw[j][1][1]; a1[2] += bflo(w[j].w) * cw[j][1][2]; a1[3] += bfhi(w[j].w) * cw[j][1][3]; }
            u32x4 pk; pk.x = pk2(a0[0], a0[1]); pk.y = pk2(a0[2], a0[3]); pk.z = pk2(a1[0], a1[1]); pk.w = pk2(a1[2], a1[3]);
            xa[m][kk] = __builtin_bit_cast(bf16x8, pk);
        }
    }
#pragma unroll
    for (int nn = 0; nn < 4; ++nn) c8[nn] = 8.f * (fmaxf(-c8[nn], 0.f) + log1pf(expf(-fabsf(c8[nn]))));
#pragma unroll
    for (int nn = 0; nn < 4; ++nn) {
        asm volatile("" ::: "memory");
        const int e = 64 * wave + 16 * nn + fr;
        bf16x8 wa[2], wx[2];
#pragma unroll
        for (int kk = 0; kk < 2; ++kk) { wa[kk] = wan[kk]; wx[kk] = wxn[kk]; }
        if (nn < 3) {
#pragma unroll
            for (int kk = 0; kk < 2; ++kk) { wan[kk] = *(const bf16x8*)(WG + ((size_t)(wave) * 64 + 16 * (nn + 1) + fr) * 64 + 32 * kk + 8 * fq); wxn[kk] = *(const bf16x8*)(WG + ((size_t)(8 + wave) * 64 + 16 * (nn + 1) + fr) * 64 + 32 * kk + 8 * fq); }
        }
        bf16x8 idm[2];
#pragma unroll
        for (int kk = 0; kk < 2; ++kk) {
            const int idx = 16 * nn + fr - 32 * kk - 8 * fq;
            bf16x8 t;
#pragma unroll
            for (int i = 0; i < 8; ++i) t[i] = (idx == i) ? (short)0x3F80 : (short)0;
            idm[kk] = t;
        }
        float hl[16], al[16]; float H = 0.f, A = 1.f;
#pragma unroll
        for (int m = 0; m < 4; ++m) {
            f32x4 ga = {0.f, 0.f, 0.f, 0.f}, gx = ga, xc = ga;
#pragma unroll
            for (int kk = 0; kk < 2; ++kk) {
                ga = __builtin_amdgcn_mfma_f32_16x16x32_bf16(xa[m][kk], wa[kk], ga, 0, 0, 0);
                gx = __builtin_amdgcn_mfma_f32_16x16x32_bf16(xa[m][kk], wx[kk], gx, 0, 0, 0);
                xc = __builtin_amdgcn_mfma_f32_16x16x32_bf16(xa[m][kk], idm[kk], xc, 0, 0, 0);
            }
#pragma unroll
            for (int jj = 0; jj < 4; ++jj) {
                const float r = sigmoidf_(ga[jj] + ba[nn]), ig = sigmoidf_(gx[jj] + bx[nn]);
                const float la = -c8[nn] * r;
                const float a = ex2(la * LOG2E);
                const float t2 = 2.f * la;
                const float om = (t2 > -0.004f) ? -t2 * (1.f + 0.5f * t2) : (1.f - a * a);
                const float uu = __builtin_amdgcn_sqrtf(om) * (ig * xc[jj]);
                A *= a; H = a * H + uu; hl[4 * m + jj] = H; al[4 * m + jj] = A;
            }
        }
        float Ai = A, Hi = H;
        { const float Ap = __shfl_up(Ai, 16), Hp = __shfl_up(Hi, 16); if (fq >= 1) { Hi = Ai * Hp + Hi; Ai = Ai * Ap; } }
        { const float Ap = __shfl_up(Ai, 32), Hp = __shfl_up(Hi, 32); if (fq >= 2) { Hi = Ai * Hp + Hi; Ai = Ai * Ap; } }
        float Pin = __shfl_up(Ai, 16), Hin = __shfl_up(Hi, 16); if (fq == 0) { Pin = 1.f; Hin = 0.f; }
#pragma unroll
        for (int k = 0; k < 16; ++k) {
            const float hv = hl[k] + al[k] * Hin, av = al[k] * Pin;
            *(LAS unsigned*)(stg + (16 * fq + k) * 272 + (16 * nn + fr) * 4) = pk2(hv, av);
        }
        if (fq == 3) { const size_t ao = ((size_t)b * NLT + c) * LW + e; AGGA[ao] = Ai; AGGH[ao] = Hi; }
    }
#pragma unroll 4
    for (int k = 0; k < 16; ++k) { const int row = 4 * k + (lane >> 4), ch = lane & 15;
        const u32x4 w = *(const LAS u32x4*)(stg + row * 272 + ch * 16);
        __builtin_nontemporal_store(w, (u32x4*)(HLAC + (rowbase + tb + row) * LW + 64 * wave + 4 * ch)); }
}

namespace att {
constexpr int KST = 144, VST = 192, KB = 64 * KST, VB = 64 * VST, BUF = KB + VB + 256;
constexpr int OST = 2 * BUF, OSTW = 32 * 144;
typedef short v4i16_t __attribute__((ext_vector_type(4)));
__device__ __forceinline__ s16x4 vtr(const LAS unsigned char* p) { return __builtin_bit_cast(s16x4, __builtin_amdgcn_ds_read_tr16_b64_v4i16((LAS v4i16_t*)p)); }
__device__ __forceinline__ float max3f(float a, float b, float c) { float r; asm("v_max3_f32 %0, %1, %2, %3" : "=v"(r) : "v"(a), "v"(b), "v"(c)); return r; }
struct TileRegs { u32x4 k, v; float f; };
struct UnitPre { bf16x8 qf[4]; float Fref, Fend; TileRegs t; };
__device__ __forceinline__ void unit_of(int i, int G, int& b, int& h, int& qb) { const int rest = i >> 4, r = i & 15; qb = ((i / G) & 1) ? r : 15 - r; b = rest & 15; h = rest >> 4; }
__device__ __forceinline__ TileRegs load_tile(const bf16* kg, const bf16* vg, const float* F, int j, int tid) {
    TileRegs t; t.k = *(const u32x4*)(kg + (size_t)(64 * j) * AW); t.v = *(const u32x4*)(vg + (size_t)(64 * j) * AW); t.f = 0.f; if (tid < 64) t.f = F[64 * j + tid]; return t; }
__device__ __forceinline__ void store_tile(LAS unsigned char* bb, const TileRegs& t, float Fref, int krow, int kch, int tid) {
    *(LAS u32x4*)(bb + krow * KST + kch * 16) = t.k; *(LAS u32x4*)(bb + KB + krow * VST + kch * 16) = t.v; if (tid < 64) ((LAS float*)(bb + KB + VB))[tid] = (Fref - t.f) * LOG2E; }
__device__ __forceinline__ void unit_of512(int i, int G, int& b, int& h, int& qb) { const int rest = i >> 3, r = i & 7; qb = ((i / G) & 1) ? r : 7 - r; b = rest & 15; h = rest >> 4; }
__device__ __forceinline__ void mask_blk(f32x16& p0, f32x16& p1, int kq) {
#pragma unroll
    for (int jj = 0; jj < 16; ++jj) { const int kl = (jj & 7) + 16 * (jj >> 3); if (kl > kq) p0[jj] = -INFINITY; if (kl + 32 > kq) p1[jj] = -INFINITY; }
}
__device__ __forceinline__ float max32(const f32x16& a, const f32x16& b) {
    float ma = max3f(a[0], a[1], b[0]), mb = max3f(a[2], a[3], b[1]); ma = max3f(ma, b[2], b[3]);
#pragma unroll
    for (int jj = 4; jj < 16; jj += 4) { ma = max3f(ma, a[jj], a[jj + 1]); mb = max3f(mb, a[jj + 2], a[jj + 3]); ma = max3f(ma, b[jj], b[jj + 1]); mb = max3f(mb, b[jj + 2], b[jj + 3]); }
    float mx = max3f(ma, mb, mb);
    return max3f(mx, __shfl_xor(mx, 32), mx);
}
__device__ __forceinline__ void softmax_blk(f32x16& p0, f32x16& p1, f32x16& o0, f32x16& o1, float& mrun, float& lrun, bf16x8 (&pb)[4]) {
    const float mx = max32(p0, p1);
    if (__any(mx > mrun + 8.f)) {
        const float mnew = max3f(mrun, mx, mx), alpha = ex2(mrun - mnew);
        mrun = mnew; lrun *= alpha;
#pragma unroll
        for (int jj = 0; jj < 16; ++jj) { o0[jj] *= alpha; o1[jj] *= alpha; }
    }
    p0 = p0 - mrun; p1 = p1 - mrun;
#pragma unroll
    for (int jj = 0; jj < 16; ++jj) { p0[jj] = ex2(p0[jj]); p1[jj] = ex2(p1[jj]); }
    { const f32x16 sv = p0 + p1; const f32x4 s4 = (f32x4){sv[0], sv[1], sv[2], sv[3]} + (f32x4){sv[4], sv[5], sv[6], sv[7]} + (f32x4){sv[8], sv[9], sv[10], sv[11]} + (f32x4){sv[12], sv[13], sv[14], sv[15]};
      lrun += (s4[0] + s4[1]) + (s4[2] + s4[3]); }
#pragma unroll
    for (int c = 0; c < 4; ++c) { u32x4 w;
        if (c < 2) { w.x = pk2(p0[8 * c], p0[8 * c + 1]); w.y = pk2(p0[8 * c + 2], p0[8 * c + 3]); w.z = pk2(p0[8 * c + 4], p0[8 * c + 5]); w.w = pk2(p0[8 * c + 6], p0[8 * c + 7]); }
        else { const int c2 = c - 2; w.x = pk2(p1[8 * c2], p1[8 * c2 + 1]); w.y = pk2(p1[8 * c2 + 2], p1[8 * c2 + 3]); w.z = pk2(p1[8 * c2 + 4], p1[8 * c2 + 5]); w.w = pk2(p1[8 * c2 + 6], p1[8 * c2 + 7]); }
        pb[c] = __builtin_bit_cast(bf16x8, w); }
}
__device__ __forceinline__ void store_o(LAS unsigned char* stg, const f32x16& o0, const f32x16& o1, float inv, int r32, int hi) {
#pragma unroll
    for (int g = 0; g < 4; ++g) {
        u32x2 w0, w1;
        w0.x = pk2(o0[4 * g] * inv, o0[4 * g + 1] * inv); w0.y = pk2(o0[4 * g + 2] * inv, o0[4 * g + 3] * inv);
        w1.x = pk2(o1[4 * g] * inv, o1[4 * g + 1] * inv); w1.y = pk2(o1[4 * g + 2] * inv, o1[4 * g + 3] * inv);
        *(LAS u32x2*)(stg + r32 * 144 + (8 * g + 4 * hi) * 2) = w0; *(LAS u32x2*)(stg + r32 * 144 + (32 + 8 * g + 4 * hi) * 2) = w1;
    }
}
__device__ __forceinline__ void attn_phase(const Params& P, LAS unsigned char* lds, int bx, int G, int tid, int wave, int lane, float skip_thr) {
    const int r32 = lane & 31, hi = lane >> 5, krow = tid >> 3, kch = tid & 7;
    const int NU = BATCH * NH * 8;
    const int pr = (r32 & ~12) | ((r32 & 4) << 1) | ((r32 & 8) >> 1);
    const int koff = pr * KST + 16 * hi;
    const int voff = (8 * hi + ((lane & 15) >> 2)) * VST + (16 * ((lane >> 4) & 1) + 4 * (lane & 3)) * 2;
    const bf16* Q = (const bf16*)(P.ws + WS_Q); const bf16* K = (const bf16*)(P.ws + WS_Q + SZ_T); const bf16* V = (const bf16*)(P.ws + WS_Q + 2 * SZ_T);
    bf16* O = (bf16*)(P.ws + WS_ATT);
    for (int i = bx; i < NU; i += G) {
        int b, h, qb; unit_of512(i, G, b, h, qb);
        const float* F = (const float*)(P.ws + WS_F) + ((size_t)b * NH + h) * SEQ;
        const size_t rowbase = (size_t)b * SEQ; const int t0 = qb * 512;
        const int NT = (t0 + 512) / 64;
        const int jd = (t0 + 64 * wave) >> 6;
        const int qposA = t0 + 64 * wave + r32;
        bf16x8 qa[4], qb_[4];
        { const bf16* qp = Q + (rowbase + qposA) * AW + h * HD + 8 * hi;
#pragma unroll
          for (int ds = 0; ds < 4; ++ds) { qa[ds] = __builtin_nontemporal_load((const bf16x8*)(qp + 16 * ds)); qb_[ds] = __builtin_nontemporal_load((const bf16x8*)(qp + (size_t)32 * AW + 16 * ds)); } }
        const float Fref = F[t0];
        int j0;
        {
            const int jl = (lane < NT) ? lane : (NT - 1);
            const float bl = (Fref - F[64 * jl + 63]) * LOG2E;
            const unsigned long long mk = __ballot((lane < NT) && (bl >= skip_thr));
            j0 = mk ? (int)__builtin_ctzll(mk) : (NT - 1);
            j0 = __builtin_amdgcn_readfirstlane(j0);
            if (j0 > NT - 8) j0 = NT - 8;
        }
        const bf16* kg = K + (rowbase + krow) * AW + h * HD + kch * 8;
        const bf16* vg = V + (rowbase + krow) * AW + h * HD + kch * 8;
        { const TileRegs t = load_tile(kg, vg, F, NT - 1, tid); store_tile(lds, t, Fref, krow, kch, tid); }
        __syncthreads();
        f32x16 oa0 = {}, oa1 = {}, ob0 = {}, ob1 = {}; float ma = -1e30f, la = 0.f, mb = -1e30f, lb = 0.f;
        for (int j = NT - 1; j >= j0; --j) {
            const int cur = (NT - 1 - j) & 1;
            TileRegs n1 = {};
            if (j > j0) n1 = load_tile(kg, vg, F, j - 1, tid);
            if (j <= jd) {
                const LAS unsigned char* bb = lds + cur * BUF;
                const LAS float* Bl = (const LAS float*)(bb + KB + VB);
                f32x16 a0, a1, b0, b1;
#pragma unroll
                for (int g = 0; g < 4; ++g) { const f32x4 t = *(const LAS f32x4*)(Bl + 8 * hi + 16 * (g >> 1) + 4 * (g & 1)); const f32x4 u = *(const LAS f32x4*)(Bl + 32 + 8 * hi + 16 * (g >> 1) + 4 * (g & 1));
#pragma unroll
                    for (int q = 0; q < 4; ++q) { a0[4 * g + q] = t[q]; a1[4 * g + q] = u[q]; b0[4 * g + q] = t[q]; b1[4 * g + q] = u[q]; } }
#pragma unroll
                for (int ds = 0; ds < 4; ++ds) {
                    const bf16x8 k0 = *(const LAS bf16x8*)(bb + koff + 32 * ds), k1 = *(const LAS bf16x8*)(bb + koff + 32 * KST + 32 * ds);
                    a0 = __builtin_amdgcn_mfma_f32_32x32x16_bf16(k0, qa[ds], a0, 0, 0, 0);
                    a1 = __builtin_amdgcn_mfma_f32_32x32x16_bf16(k1, qa[ds], a1, 0, 0, 0);
                    b0 = __builtin_amdgcn_mfma_f32_32x32x16_bf16(k0, qb_[ds], b0, 0, 0, 0);
                    b1 = __builtin_amdgcn_mfma_f32_32x32x16_bf16(k1, qb_[ds], b1, 0, 0, 0);
                }
                asm volatile("s_nop 15\n\ts_nop 7" : "+v"(a0), "+v"(a1), "+v"(b0), "+v"(b1));
                if (j == jd) { const int kq = qposA - 64 * j - 8 * hi; mask_blk(a0, a1, kq); mask_blk(b0, b1, kq + 32); }
                bf16x8 pa[4], pbb[4];
                softmax_blk(a0, a1, oa0, oa1, ma, la, pa);
                softmax_blk(b0, b1, ob0, ob1, mb, lb, pbb);
                const LAS unsigned char* vb = bb + KB + voff;
#pragma unroll
                for (int c = 0; c < 4; ++c) {
                    const s16x4 x0 = vtr(vb + (16 * c) * VST), x1 = vtr(vb + (16 * c + 4) * VST);
                    const s16x4 y0 = vtr(vb + (16 * c) * VST + 64), y1 = vtr(vb + (16 * c + 4) * VST + 64);
                    const bf16x8 va = {x0[0], x0[1], x0[2], x0[3], x1[0], x1[1], x1[2], x1[3]};
                    const bf16x8 vb2 = {y0[0], y0[1], y0[2], y0[3], y1[0], y1[1], y1[2], y1[3]};
                    oa0 = __builtin_amdgcn_mfma_f32_32x32x16_bf16(va, pa[c], oa0, 0, 0, 0);
                    oa1 = __builtin_amdgcn_mfma_f32_32x32x16_bf16(vb2, pa[c], oa1, 0, 0, 0);
                    ob0 = __builtin_amdgcn_mfma_f32_32x32x16_bf16(va, pbb[c], ob0, 0, 0, 0);
                    ob1 = __builtin_amdgcn_mfma_f32_32x32x16_bf16(vb2, pbb[c], ob1, 0, 0, 0);
                }
            }
            if (j > j0) store_tile(lds + (cur ^ 1) * BUF, n1, Fref, krow, kch, tid);
            __syncthreads();
        }
        LAS unsigned char* stg = lds + OST + wave * (2 * OSTW);
        { const float lta = la + __shfl_xor(la, 32), ltb = lb + __shfl_xor(lb, 32);
          store_o(stg, oa0, oa1, 1.f / lta, r32, hi); store_o(stg + OSTW, ob0, ob1, 1.f / ltb, r32, hi); }
        bf16* ow = O + (rowbase + t0 + 64 * wave) * AW + h * HD;
#pragma unroll
        for (int q = 0; q < 8; ++q) { const int row = 8 * q + (lane >> 3), ch = lane & 7;
            const u32x4 v = *(const LAS u32x4*)(stg + row * 144 + ch * 16);
            __builtin_nontemporal_store(v, (u32x4*)(ow + (size_t)row * AW + ch * 8)); }
        __syncthreads();
    }
}
}

__device__ __forceinline__ void mix_superunit(const Params& P, int su, LAS unsigned char* lds, int tid, int wave, int lane) {
    const int b = su >> 4, c0 = 4 * (su & 15);
    const bf16* ATT = (const bf16*)(P.ws + WS_ATT); const unsigned* HLAC = (const unsigned*)(P.ws + WS_HL);
    const bf16* LG = (const bf16*)(P.ws + WS_Q + 4 * SZ_T); bf16* MX = (bf16*)(P.ws + WS_HA);
    const float* AGGA = (const float*)(P.ws + WS_AGGA) + (size_t)b * NLT * LW + tid; const float* AGGH = (const float*)(P.ws + WS_AGGH) + (size_t)b * NLT * LW + tid;
    LAS float* carr = (LAS float*)lds;
    float carry = 0.f;
    {
        int c = 0;
        for (; c + 8 <= c0; c += 8) { float a[8], h[8];
#pragma unroll
            for (int i = 0; i < 8; ++i) { a[i] = AGGA[(c + i) * LW]; h[i] = AGGH[(c + i) * LW]; }
#pragma unroll
            for (int i = 0; i < 8; ++i) carry = h[i] + a[i] * carry; }
        if (c < c0) { float a[4], h[4];
#pragma unroll
            for (int i = 0; i < 4; ++i) { a[i] = AGGA[(c + i) * LW]; h[i] = AGGH[(c + i) * LW]; }
#pragma unroll
            for (int i = 0; i < 4; ++i) carry = h[i] + a[i] * carry; }
    }
    f32x4 ga[2], gr[2];
    ga[0] = *(const f32x4*)(P.att_g + 8 * lane); ga[1] = *(const f32x4*)(P.att_g + 8 * lane + 4);
    gr[0] = *(const f32x4*)(P.lru_g + 8 * lane); gr[1] = *(const f32x4*)(P.lru_g + 8 * lane + 4);
    for (int cc = 0; cc < 4; ++cc) {
        const int c = c0 + cc;
        const float nA = AGGA[c * LW], nH = AGGH[c * LW];
        carr[tid] = carry; __syncthreads();
        const f32x4 cr0 = *(const LAS f32x4*)(carr + 8 * lane), cr1 = *(const LAS f32x4*)(carr + 8 * lane + 4);
        const float crv[8] = {cr0[0], cr0[1], cr0[2], cr0[3], cr1[0], cr1[1], cr1[2], cr1[3]};
#pragma unroll 1
        for (int rg = 0; rg < 2; ++rg) {
            u32x4 wa[4], wg[4], wp[4][2];
#pragma unroll
            for (int r = 0; r < 4; ++r) { const size_t row = (size_t)b * SEQ + c * LT + 8 * wave + 4 * rg + r;
                wa[r] = __builtin_nontemporal_load((const u32x4*)(ATT + row * AW + 8 * lane)); wg[r] = __builtin_nontemporal_load((const u32x4*)(LG + row * LW + 8 * lane));
                wp[r][0] = __builtin_nontemporal_load((const u32x4*)(HLAC + row * LW + 8 * lane)); wp[r][1] = __builtin_nontemporal_load((const u32x4*)(HLAC + row * LW + 8 * lane + 4)); }
#pragma unroll
            for (int r = 0; r < 4; ++r) { const size_t row = (size_t)b * SEQ + c * LT + 8 * wave + 4 * rg + r;
                float av[8], rv[8];
#pragma unroll
                for (int i = 0; i < 4; ++i) { av[2 * i] = bflo(wa[r][i]); av[2 * i + 1] = bfhi(wa[r][i]);
                    const unsigned p0 = wp[r][i >> 1][2 * (i & 1)], p1 = wp[r][i >> 1][2 * (i & 1) + 1];
                    const float h0 = bflo(p0) + bfhi(p0) * crv[2 * i], h1 = bflo(p1) + bfhi(p1) * crv[2 * i + 1];
                    const float g0 = bflo(wg[r][i]), g1 = bfhi(wg[r][i]);
                    const float y0 = 0.7978845608f * (g0 + 0.044715f * g0 * g0 * g0), y1 = 0.7978845608f * (g1 + 0.044715f * g1 * g1 * g1);
                    rv[2 * i] = h0 * g0 * sigmoidf_(2.f * y0); rv[2 * i + 1] = h1 * g1 * sigmoidf_(2.f * y1); }
                float sa = 0.f, sr = 0.f;
#pragma unroll
                for (int i = 0; i < 8; ++i) { sa += av[i] * av[i]; sr += rv[i] * rv[i]; }
                sa = wave_sum(sa); sr = wave_sum(sr);
                const float ra = rsqrtf(sa * (1.f / AW) + NORM_EPS), rr = rsqrtf(sr * (1.f / LW) + NORM_EPS);
                u32x4 oa, orr;
                oa.x = pk2(av[0] * ra * ga[0][0], av[1] * ra * ga[0][1]); oa.y = pk2(av[2] * ra * ga[0][2], av[3] * ra * ga[0][3]);
                oa.z = pk2(av[4] * ra * ga[1][0], av[5] * ra * ga[1][1]); oa.w = pk2(av[6] * ra * ga[1][2], av[7] * ra * ga[1][3]);
                orr.x = pk2(rv[0] * rr * gr[0][0], rv[1] * rr * gr[0][1]); orr.y = pk2(rv[2] * rr * gr[0][2], rv[3] * rr * gr[0][3]);
                orr.z = pk2(rv[4] * rr * gr[1][0], rv[5] * rr * gr[1][1]); orr.w = pk2(rv[6] * rr * gr[1][2], rv[7] * rr * gr[1][3]);
                *(u32x4*)(MX + row * DM + 8 * lane) = oa; *(u32x4*)(MX + row * DM + AW + 8 * lane) = orr;
            }
        }
        carry = nH + nA * carry;
        __syncthreads();
    }
}

#define XB_TMO      128
#define XB_XCNT(j)  (256  + 64 * (j))
#define XB_XSUB(j)  (1280 + 64 * (j))
#define XB_XGEN(j)  (2304 + 64 * (j))
#define XB_TOP      3328
#define XB_TOPGEN   3392
#define XCD_BAR_WORDS 3456
#define XB_SPIN_CAP (1u << 18)

__device__ __forceinline__ unsigned xb_ld(unsigned* p)              { return __hip_atomic_load(p, __ATOMIC_RELAXED, __HIP_MEMORY_SCOPE_AGENT); }
__device__ __forceinline__ unsigned xb_add(unsigned* p, unsigned v) { return __hip_atomic_fetch_add(p, v, __ATOMIC_RELAXED, __HIP_MEMORY_SCOPE_AGENT); }
__device__ __forceinline__ unsigned xb_xcc_id() { return (unsigned)__builtin_amdgcn_s_getreg((3 << 11) | 20) & 0xFu; }
#define XB_SPIN(cond, bar) do { unsigned _sp = 0; while (cond) { __builtin_amdgcn_s_sleep(1); \
    if ((++_sp & 255u) == 0u) { if (xb_ld(&(bar)[XB_TMO])) break; if (_sp > XB_SPIN_CAP) { atomicAdd(&(bar)[XB_TMO], 1u); break; } } } } while (0)

struct XcdBarrier {
    unsigned* bar; unsigned x;
    volatile LAS unsigned* st;
};

__device__ __forceinline__ XcdBarrier xcd_barrier_post(unsigned* bar, volatile LAS unsigned* st) {
    XcdBarrier b; b.bar = bar; b.x = xb_xcc_id(); b.st = st;
    if (threadIdx.x == 0) (void)xb_add(&bar[XB_XCNT(b.x)], 1u);
    return b;
}
__device__ __forceinline__ void xcd_barrier_complete(unsigned* bar, unsigned x, unsigned& nloc, unsigned& nx) {
    const unsigned G = gridDim.x * gridDim.y * gridDim.z;
    unsigned sum, cnt, mine, sp = 0u;
    for (;;) {
        sum = 0u; cnt = 0u; mine = 0u;
#pragma unroll
        for (unsigned j = 0; j < 16; ++j) { const unsigned c = xb_ld(&bar[XB_XCNT(j)]); sum += c; cnt += (c > 0u) ? 1u : 0u; mine = (j == x) ? c : mine; }
        if (sum == G) break;
        __builtin_amdgcn_s_sleep(1);
        if ((++sp & 255u) == 0u) { if (xb_ld(&bar[XB_TMO])) break; if (sp > XB_SPIN_CAP) { atomicAdd(&bar[XB_TMO], 1u); break; } }
    }
    nloc = mine > 0u ? mine : 1u; nx = cnt > 0u ? cnt : 1u;
}

__device__ __forceinline__ void xcd_barrier(const XcdBarrier& b) {
    asm volatile("s_waitcnt vmcnt(0)" ::: "memory");
    __syncthreads();
    if (threadIdx.x == 0) {
        unsigned* bar = b.bar;
        __builtin_amdgcn_s_waitcnt(0);
        unsigned nloc = b.st[0], nx = b.st[1];
        if (nloc == 0u) { xcd_barrier_complete(bar, b.x, nloc, nx); b.st[0] = nloc; b.st[1] = nx; }
        const unsigned old = xb_add(&bar[XB_XSUB(b.x)], 1u);
        const unsigned gen = old / nloc;
        if (old + 1u == (gen + 1u) * nloc) {
            __builtin_amdgcn_fence(__ATOMIC_RELEASE, "agent");
            asm volatile("s_waitcnt vmcnt(0)" ::: "memory");
            const unsigned og = xb_add(&bar[XB_TOP], 1u);
            const unsigned tg = og / nx;
            if (og + 1u == (tg + 1u) * nx) xb_add(&bar[XB_TOPGEN], 1u);
            else XB_SPIN(xb_ld(&bar[XB_TOPGEN]) == tg, bar);
            __builtin_amdgcn_fence(__ATOMIC_ACQUIRE, "agent");
            xb_add(&bar[XB_XGEN(b.x)], 1u);
            asm volatile("s_waitcnt vmcnt(0)" ::: "memory");
        } else {
            XB_SPIN(xb_ld(&bar[XB_XGEN(b.x)]) == gen, bar);
            __builtin_amdgcn_fence(__ATOMIC_ACQUIRE, "agent");
            asm volatile("s_waitcnt vmcnt(0)" ::: "memory");
        }
    }
    __syncthreads();
}

#ifndef REP_P0
#define REP_P0 1
#endif
#ifndef REP_LRU
#define REP_LRU 1
#endif
#ifndef REP_ATT
#define REP_ATT 1
#endif
#ifndef REP_MIX
#define REP_MIX 1
#endif
#ifndef REP_G4
#define REP_G4 1
#endif
constexpr int LDS_BARST = 147456;
constexpr int LDS_BYTES = 147456 + 256;
__global__ void __launch_bounds__(NTHREADS) hymba_fwd(Params P) {
    extern __shared__ __attribute__((aligned(16))) unsigned char lds_raw[];
    LAS unsigned char* lds = (LAS unsigned char*)lds_raw;
    cg::grid_group grid = cg::this_grid();
    const int tid = threadIdx.x, lane = tid & 63, wave = __builtin_amdgcn_readfirstlane(tid >> 6);
    const int G = gridDim.x, bx = blockIdx.x;
    const int gw = bx * NWAVES + wave, ngw = G * NWAVES;
    bf16* HA = (bf16*)(P.ws + WS_HA);
    volatile LAS unsigned* barst = (volatile LAS unsigned*)(lds + LDS_BARST);
    if (tid < 2) barst[tid] = 0u;
    if (bx == 0) for (int i = tid; i < XCD_BAR_WORDS; i += NTHREADS) ((unsigned*)(P.ws + WS_BAR))[i] = 0u;
    __syncthreads();
    grid.sync();
    const XcdBarrier xbar = xcd_barrier_post((unsigned*)(P.ws + WS_BAR), barst);

    p0_weights(P, lds, gw, ngw, wave, lane);
    for (int i = bx * NTHREADS + tid; i < M; i += G * NTHREADS) ((float*)(P.ws + WS_RSS))[i] = 0.f;
    for (int rep = 0; rep < REP_P0; ++rep) row_pass<true>(P.x, P.norm1_g, HA, P.w_in, P.b_f, (float*)(P.ws + WS_LOGF), gw, ngw, lane);
    xcd_barrier(xbar);

    if (wave == 0) for (int s = bx; s < BATCH * NH; s += G) cumsum_seq((const float*)(P.ws + WS_LOGF), (float*)(P.ws + WS_F), s, lane);
    {
        pg8::Gemm g{HA, (const pg8::bf16_t*)(P.ws + WS_W1), M, NPROJ, DM}; pg8::StaticOrder S; S.init(M, NPROJ, G, bx);
        pg8::EpiProj E{(pg8::bf16_t*)(P.ws + WS_Q), SZ_T / 2, P.q_g, P.k_g, QSCALE};
        pg8::gemm_phase<pg8::EpiProj, pg8::StaticOrder, true, true>(lds, g, S, E);
    }
    xcd_barrier(xbar);

    for (int rep = 0; rep < REP_LRU; ++rep) for (int u = bx; u < BATCH * NLT; u += G) lru_unit(P, u / NLT, u % NLT, lds, wave, lane);
    __syncthreads();
    {
        float gqm = 0.f, gkm = 0.f;
        gqm = fabsf(P.q_g[lane]); gkm = fabsf(P.k_g[lane]);
#pragma unroll
        for (int o = 1; o < 64; o <<= 1) { gqm = fmaxf(gqm, __shfl_xor(gqm, o)); gkm = fmaxf(gkm, __shfl_xor(gkm, o)); }
        const float skip_thr = -(2.f * 1.05f * 8.f * gqm * gkm * LOG2E + 40.f);
        for (int rep = 0; rep < REP_ATT; ++rep) att::attn_phase(P, lds, bx, G, tid, wave, lane, skip_thr);
    }
    xcd_barrier(xbar);

    for (int rep = 0; rep < REP_MIX; ++rep) for (int su = bx; su < BATCH * 16; su += G) mix_superunit(P, su, lds, tid, wave, lane);
    xcd_barrier(xbar);

    {
        pg8::Gemm g{HA, (const pg8::bf16_t*)(P.ws + WS_WO), M, DM, DM}; pg8::StaticOrder S; S.init(M, DM, G, bx);
        pg8::EpiResNorm E{P.x, (pg8::bf16_t*)(P.ws + WS_XB), (float*)(P.ws + WS_RSS), DM};
        pg8::gemm_phase<pg8::EpiResNorm, pg8::StaticOrder, true, true>(lds, g, S, E);
    }
    xcd_barrier(xbar);

    {
        pg8::Gemm g{(const pg8::bf16_t*)(P.ws + WS_XB), (const pg8::bf16_t*)(P.ws + WS_WGU), M, 2 * DFF, DM}; pg8::StaticOrder S; S.init(M, 2 * DFF, G, bx);
        pg8::EpiSwiGLU E{(pg8::bf16_t*)(P.ws + WS_ACT), DFF, (const float*)(P.ws + WS_RSS)};
        for (int rep = 0; rep < REP_G4; ++rep) pg8::gemm_phase<pg8::EpiSwiGLU, pg8::StaticOrder, true, true>(lds, g, S, E);
    }
    xcd_barrier(xbar);

    {
        pg8::Gemm g{(const pg8::bf16_t*)(P.ws + WS_ACT), (const pg8::bf16_t*)(P.ws + WS_WD), M, DM, DFF}; pg8::StaticOrder S; S.init(M, DM, G, bx);
        pg8::EpiRes E{(const pg8::bf16_t*)(P.ws + WS_XB), P.out, DM};
        pg8::gemm_phase<pg8::EpiRes, pg8::StaticOrder, true, true>(lds, g, S, E);
    }
}

extern "C" void kernel_launch(void* const* d_in, const int* in_sizes, int n_in, void* d_out, int out_size, void* d_ws, size_t ws_size, hipStream_t stream) {
    static int grid = 0;
    if (grid == 0) {
        if (n_in != 20 || in_sizes[0] != M * DM || out_size != M * DM || ws_size < WS_END) { fprintf(stderr, "kernel_launch: unexpected shapes (n_in %d, ws %zu)\n", n_in, ws_size); grid = -1; return; }
        int dev = 0, cus = 0, per_cu = 0;
        (void)hipGetDevice(&dev); (void)hipDeviceGetAttribute(&cus, hipDeviceAttributeMultiprocessorCount, dev);
        (void)hipFuncSetAttribute((const void*)hymba_fwd, hipFuncAttributeMaxDynamicSharedMemorySize, LDS_BYTES);
        if (hipOccupancyMaxActiveBlocksPerMultiprocessor(&per_cu, (const void*)hymba_fwd, NTHREADS, LDS_BYTES) != hipSuccess || per_cu < 1) { fprintf(stderr, "kernel_launch: occupancy query failed (%d)\n", per_cu); grid = -1; return; }
        grid = cus * per_cu;
    }
    if (grid < 0) return;
    Params p{};
    const float** pp = (const float**)&p;
    for (int i = 0; i < 20; ++i) pp[i] = (const float*)d_in[i];
    p.out = (float*)d_out; p.ws = (unsigned char*)d_ws;
    void* args[] = {&p};
    hipError_t e = hipLaunchCooperativeKernel((const void*)hymba_fwd, dim3(grid), dim3(NTHREADS), args, LDS_BYTES, stream);
    if (e != hipSuccess) fprintf(stderr, "cooperative launch failed: %s (grid %d)\n", hipGetErrorString(e), grid);
}
```
